# Optimizing an MI355X kernel written in HIP

```python
import jax, jax.numpy as jnp
from jax import lax
import numpy as np

D_MODEL = 2048
BATCH = 2
SEQ = 16384
DEPTH = 4

CTX_LEN = 256
GRID_W = 64
HEAD_DIM = 128
N_HEADS = (D_MODEL // 2) // HEAD_DIM
N_KV_HEADS = N_HEADS // 4
GQA_GROUP = N_HEADS // N_KV_HEADS
Q_WIDTH = N_HEADS * HEAD_DIM
KV_WIDTH = N_KV_HEADS * HEAD_DIM
N_FOURIER_GROUPS = 4
FOURIER_WIDTH = D_MODEL // 2
FOURIER_GROUP_DIM = FOURIER_WIDTH // N_FOURIER_GROUPS
EVEN_IN_WIDTH = FOURIER_WIDTH + Q_WIDTH + 2 * KV_WIDTH
EVEN_MIX_WIDTH = FOURIER_WIDTH + Q_WIDTH
WINDOW = 128
BLOCK = 128
ATTN_SCALE = HEAD_DIM ** -0.5
ROPE_THETA = 10000.0
ROPE_AXIS_DIM = HEAD_DIM // 2
CONV_WIDTH = 3
CONV_DIM = D_MODEL
D_FF = 4 * D_MODEL
N_MOD = 6
NORM_EPS = 1e-6
NEG_INF = -1e30

kernel_name = "hybrid_fourier_swa_shortconv_dit"


def rmsnorm(t, gain):
    tf = t.astype(jnp.float32)
    tf = tf * lax.rsqrt(jnp.mean(tf * tf, axis=-1, keepdims=True) + NORM_EPS)
    return tf.astype(t.dtype) * gain


def modulate(t, gain, shift, scale):
    return rmsnorm(t, gain) * (1 + scale) + shift


def axial_rope_tables(n_tok):
    rows = n_tok // GRID_W
    row = jnp.repeat(jnp.arange(rows, dtype=jnp.float32), GRID_W)
    col = jnp.tile(jnp.arange(GRID_W, dtype=jnp.float32), rows)
    inv_freq = ROPE_THETA ** (-jnp.arange(0, ROPE_AXIS_DIM, 2, dtype=jnp.float32) / ROPE_AXIS_DIM)
    ang = jnp.stack([row[:, None] * inv_freq, col[:, None] * inv_freq], axis=1)
    return jnp.cos(ang), jnp.sin(ang)


def apply_axial_rope(t, cos, sin):
    b, n, h, _ = t.shape
    tf = t.astype(jnp.float32).reshape(b, n, h, 2, 2, ROPE_AXIS_DIM // 2)
    t1, t2 = tf[..., 0, :], tf[..., 1, :]
    cs, sn = cos[None, :, None], sin[None, :, None]
    out = jnp.stack([t1 * cs - t2 * sn, t2 * cs + t1 * sn], axis=-2)
    return out.reshape(b, n, h, HEAD_DIM).astype(t.dtype)


def to_heads(t, n_heads):
    return t.reshape(t.shape[0], t.shape[1], n_heads, HEAD_DIM)


def fourier_mix(u):
    b, n, _ = u.shape
    ug = u.astype(jnp.float32).reshape(b, n, N_FOURIER_GROUPS, FOURIER_GROUP_DIM)
    y = jnp.fft.fft2(ug, axes=(1, 3)).real * (n * FOURIER_GROUP_DIM) ** -0.5
    return y.reshape(b, n, FOURIER_WIDTH).astype(u.dtype)


def sink_logits(sink):
    return sink.astype(jnp.float32).reshape(N_KV_HEADS, GQA_GROUP, 1, 1)


def sink_softmax(scores, sink_l):
    m = sink_l
    for s in scores:
        m = jnp.maximum(m, s.max(axis=-1, keepdims=True))
    exps = [jnp.exp(s - m) for s in scores]
    den = jnp.exp(sink_l - m)
    for e in exps:
        den = den + e.sum(axis=-1, keepdims=True)
    return [e / den for e in exps]


def band_blocks(t):
    b, n = t.shape[:2]
    tb = t.reshape(b, n // BLOCK, BLOCK, N_KV_HEADS, HEAD_DIM)
    tp = jnp.pad(tb, ((0, 0), (1, 1), (0, 0), (0, 0), (0, 0)))
    return jnp.concatenate([tp[:, :-2], tp[:, 1:-1], tp[:, 2:]], axis=2)


def window_attention(q, k, v, k_ctx, v_ctx, sink):
    b, n = q.shape[:2]
    nb = n // BLOCK
    qb = q.reshape(b, nb, BLOCK, N_KV_HEADS, GQA_GROUP, HEAD_DIM)
    kb, vb = band_blocks(k), band_blocks(v)
    s_loc = jnp.einsum('bnqkgd,bnskd->bnkgqs', qb, kb, preferred_element_type=jnp.float32) * ATTN_SCALE
    s_ctx = jnp.einsum('bnqkgd,bckd->bnkgqc', qb, k_ctx, preferred_element_type=jnp.float32) * ATTN_SCALE
    qi = jnp.arange(BLOCK)[:, None]
    kj = jnp.arange(3 * BLOCK)[None, :]
    kpos = (jnp.arange(nb)[:, None, None] - 1) * BLOCK + kj
    valid = (jnp.abs(kj - BLOCK - qi) <= WINDOW) & (kpos >= 0) & (kpos < n)
    s_loc = jnp.where(valid[None, :, None, None], s_loc, NEG_INF)
    p_loc, p_ctx = sink_softmax([s_loc, s_ctx], sink_logits(sink))
    o = (jnp.einsum('bnkgqs,bnskd->bnqkgd', p_loc.astype(v.dtype), vb)
         + jnp.einsum('bnkgqc,bckd->bnqkgd', p_ctx.astype(v.dtype), v_ctx))
    return o.reshape(b, n, Q_WIDTH)


def context_attention(q_c, k_c, v_c, sink):
    b, m = q_c.shape[:2]
    qg = q_c.reshape(b, m, N_KV_HEADS, GQA_GROUP, HEAD_DIM)
    s = jnp.einsum('bqkgd,bckd->bkgqc', qg, k_c, preferred_element_type=jnp.float32) * ATTN_SCALE
    (p,) = sink_softmax([s], sink_logits(sink))
    o = jnp.einsum('bkgqc,bckd->bqkgd', p.astype(v_c.dtype), v_c)
    return o.reshape(b, m, Q_WIDTH)


def split_even(p):
    return jnp.split(p, [FOURIER_WIDTH, FOURIER_WIDTH + Q_WIDTH, FOURIER_WIDTH + Q_WIDTH + KV_WIDTH], axis=-1)


def short_conv_mix(u, w_in, conv_w, w_out):
    gb, gc, xv = jnp.split(u @ w_in, 3, axis=-1)
    z = gc * xv
    zp = jnp.pad(z, ((0, 0), (1, 1), (0, 0)))
    y = conv_w[0] * zp[:, :-2] + conv_w[1] * zp[:, 1:-1] + conv_w[2] * zp[:, 2:]
    return (gb * y) @ w_out


def sq_relu_mlp(u, w1, w2):
    return jnp.square(jax.nn.relu(u @ w1)) @ w2


def setup_inputs(seed: int = 0) -> dict:
    key = jax.random.key(seed)
    ks = jax.random.split(key, 16)
    n_att = (DEPTH + 1) // 2
    n_conv = DEPTH // 2

    def nrm(k, shape, fan_in):
        return jax.random.normal(k, shape, jnp.float32) * fan_in ** -0.5

    return {
        "x": jax.random.normal(ks[0], (BATCH, SEQ, D_MODEL), jnp.float32),
        "c": jax.random.normal(ks[1], (BATCH, D_MODEL), jnp.float32),
        "ctx": jax.random.normal(ks[2], (BATCH, CTX_LEN, D_MODEL), jnp.float32),
        "c_ctx": jax.random.normal(ks[3], (D_MODEL,), jnp.float32),
        "w_mod": nrm(ks[4], (DEPTH, D_MODEL, N_MOD * D_MODEL), D_MODEL),
        "b_mod": 0.01 * jax.random.normal(ks[5], (DEPTH, N_MOD * D_MODEL), jnp.float32),
        "norm_gains": 1.0 + 0.01 * jax.random.normal(ks[6], (DEPTH, 4, D_MODEL), jnp.float32),
        "att_w_in": nrm(ks[7], (n_att, D_MODEL, EVEN_IN_WIDTH), D_MODEL),
        "att_sink": jax.random.normal(ks[8], (n_att, N_HEADS), jnp.float32),
        "att_w_out": nrm(ks[9], (n_att, EVEN_MIX_WIDTH, D_MODEL), EVEN_MIX_WIDTH),
        "conv_w_in": nrm(ks[10], (n_conv, D_MODEL, 3 * CONV_DIM), D_MODEL),
        "conv_w": nrm(ks[11], (n_conv, CONV_WIDTH, CONV_DIM), CONV_WIDTH),
        "conv_w_out": nrm(ks[12], (n_conv, CONV_DIM, D_MODEL), CONV_DIM),
        "mlp_w1": nrm(ks[13], (DEPTH, D_MODEL, D_FF), D_MODEL),
        "mlp_w2": nrm(ks[14], (DEPTH, D_FF, D_MODEL), D_FF),
    }


def reference(x, c, ctx, c_ctx, w_mod, b_mod, norm_gains, att_w_in, att_sink, att_w_out,
              conv_w_in, conv_w, conv_w_out, mlp_w1, mlp_w2):
    n_tok = x.shape[1]
    cos, sin = axial_rope_tables(n_tok)
    silu_c = jax.nn.silu(c)
    silu_cc = jax.nn.silu(c_ctx)
    h_ctx = ctx
    for l in range(DEPTH):
        g = norm_gains[l]
        is_attn = l % 2 == 0
        ctx_update = any(j % 2 == 0 for j in range(l + 1, DEPTH))
        sh_m, sc_m, gt_m, sh_f, sc_f, gt_f = [t[:, None] for t in
                                              jnp.split(silu_c @ w_mod[l] + b_mod[l], N_MOD, axis=-1)]
        if is_attn or ctx_update:
            csh_m, csc_m, cgt_m, csh_f, csc_f, cgt_f = jnp.split(silu_cc @ w_mod[l] + b_mod[l], N_MOD, axis=-1)

        ux = modulate(x, g[0], sh_m, sc_m)
        if is_attn:
            a = l // 2
            w_in, w_out, sink = att_w_in[a], att_w_out[a], att_sink[a]
            uc = modulate(h_ctx, g[0], csh_m, csc_m)
            if ctx_update:
                f_c, q_c, k_c, v_c = split_even(uc @ w_in)
            else:
                k_c, v_c = jnp.split(uc @ w_in[:, FOURIER_WIDTH + Q_WIDTH:], 2, axis=-1)
            k_c, v_c = to_heads(k_c, N_KV_HEADS), to_heads(v_c, N_KV_HEADS)
            f_x, q_x, k_x, v_x = split_even(ux @ w_in)
            q_x = apply_axial_rope(to_heads(q_x, N_HEADS), cos, sin)
            k_x = apply_axial_rope(to_heads(k_x, N_KV_HEADS), cos, sin)
            v_x = to_heads(v_x, N_KV_HEADS)
            attn_x = window_attention(q_x, k_x, v_x, k_c, v_c, sink)
            mix_x = jnp.concatenate([fourier_mix(f_x), attn_x], axis=-1) @ w_out
            if ctx_update:
                attn_c = context_attention(to_heads(q_c, N_HEADS), k_c, v_c, sink)
                mix_c = jnp.concatenate([fourier_mix(f_c), attn_c], axis=-1) @ w_out
        else:
            m = l // 2
            mix_x = short_conv_mix(ux, conv_w_in[m], conv_w[m], conv_w_out[m])
            if ctx_update:
                mix_c = short_conv_mix(modulate(h_ctx, g[0], csh_m, csc_m), conv_w_in[m], conv_w[m], conv_w_out[m])

        x = x + gt_m * rmsnorm(mix_x, g[1])
        x = x + gt_f * rmsnorm(sq_relu_mlp(modulate(x, g[2], sh_f, sc_f), mlp_w1[l], mlp_w2[l]), g[3])
        if ctx_update:
            h_ctx = h_ctx + cgt_m * rmsnorm(mix_c, g[1])
            h_ctx = h_ctx + cgt_f * rmsnorm(sq_relu_mlp(modulate(h_ctx, g[2], csh_f, csc_f), mlp_w1[l], mlp_w2[l]), g[3])
    return x
```

```cpp
#include <hip/hip_runtime.h>
#ifndef RESID_BF16
#define RESID_BF16 1
#endif
#include <cstdio>
#include <cstdint>


namespace pg8 {
#define PG8_LAS __attribute__((address_space(3)))
typedef unsigned short bf16_t;
typedef short bf16x8 __attribute__((ext_vector_type(8)));
typedef float f32x4 __attribute__((ext_vector_type(4)));
typedef unsigned u32x4 __attribute__((ext_vector_type(4)));
constexpr int BM = 256, BK = 64, HALF = 128, HTB = HALF * BK * 2  , STAGE_BYTES = 8 * HTB, NXCD = 8, WGM = 8;

__host__ __device__ __forceinline__ int lds_byte(int r, int c) { const int st = (r >> 4) * 2 + (c >> 5), rr = r & 15, cc = c & 31, ob = rr * 64 + cc * 2; return st * 1024 + (ob ^ (((ob >> 9) & 1) << 5)); }
__host__ __device__ __forceinline__ void stage_rc(int b, int& R, int& C) { const int st = b / 1024, sb = b % 1024, swz = sb ^ (((sb >> 9) & 1) << 5); R = (st >> 1) * 16 + swz / 64; C = (st & 1) * 32 + (swz % 64) / 2; }
__host__ __device__ __forceinline__ int perm32(int rho) { const int n = rho >> 4, i = rho & 15; return 8 * (i >> 2) + 4 * n + (i & 3); }

struct Unit { int pm, pn; };
struct Gemm { int K; unsigned pitchA, pitchB; size_t hstepA, hstepB; };

struct StaticOrder {
    int nM, nN, nwg, G, c, wgm, rev, ext_nM;
    __host__ __device__ void init(int M, int N, int G_, int c_) { nM = M / BM; nN = N / BM; nwg = nM * nN; G = G_; c = c_; wgm = WGM; rev = 0; ext_nM = 0; }
    __host__ __device__ bool next(int i, Unit& u) const {
        const long L = (long)i * G + c;
        if (L >= nwg) {
            const long L2 = L - nwg; const int nwg2 = ext_nM * nN; if (L2 >= nwg2) return false;
            int w = (int)L2; { const int q = nwg2 / NXCD, r = nwg2 % NXCD, xcd = w % NXCD, off = w / NXCD; w = (xcd < r ? xcd * (q + 1) : r * (q + 1) + (xcd - r) * q) + off; }
            u.pm = nM + w % ext_nM; u.pn = w / ext_nM; return true; }
        int wgid = (int)L; if (rev && nwg % G == 0) { const int rounds = nwg / G; wgid = (rounds - 1 - i) * G + c; }
        { const int q = nwg / NXCD, r = nwg % NXCD, xcd = wgid % NXCD, off = wgid / NXCD; wgid = (xcd < r ? xcd * (q + 1) : r * (q + 1) + (xcd - r) * q) + off; }
        const int nig = wgm * nN, gid = wgid / nig, fm = gid * wgm, gsz = (nM - fm) < wgm ? (nM - fm) : wgm;
        u.pm = fm + ((wgid % nig) % gsz); u.pn = (wgid % nig) / gsz; return true;
    }
    __device__ __forceinline__ void a_ready(const Unit&) const {}
    __device__ __forceinline__ void done(const Unit&) const {}
};


struct StdSched : StaticOrder {
    const char* A; const char* B; size_t tsA, tsB;
    __device__ __forceinline__ const char* a_ptr(const Unit& u) const { return A + (size_t)u.pm * tsA; }
    __device__ __forceinline__ const char* b_ptr(const Unit& u) const { return B + (size_t)u.pn * tsB; }
    __device__ __forceinline__ const char* a_base() const { return A; } __device__ __forceinline__ const char* b_base() const { return B; }
};
__device__ __forceinline__ Gemm std_gemm(int K) { Gemm g; g.K = K; g.pitchA = g.pitchB = (unsigned)K * 2u; g.hstepA = g.hstepB = (size_t)HALF * K * 2; return g; }
__device__ __forceinline__ StdSched std_sched(const bf16_t* A, const bf16_t* Bt, int M, int N, int K, int G, int c) { StdSched S; S.init(M, N, G, c); S.A = (const char*)A; S.B = (const char*)Bt; S.tsA = S.tsB = (size_t)BM * K * 2; return S; }
__device__ __forceinline__ unsigned cvt_pk_bf16(float lo, float hi) { unsigned r; asm volatile("v_cvt_pk_bf16_f32 %0, %1, %2" : "=v"(r) : "v"(lo), "v"(hi)); return r; }

template <int ACT  > struct EpiBf16 {
    static constexpr bool PERM = true, AFTER_DRAIN = false; static constexpr int MIN_STORES = 16;
    static __device__ __forceinline__ int brow(int R) { return (R & ~31) + perm32(R & 31); }
    bf16_t* O; int ldc;
    __device__ __forceinline__ void operator()(const f32x4 (&acc)[2][2][4][2], const Unit& u, int wr, int wc, int fr, int fq) const {
        const int row0 = u.pm * BM + wr * 64 + fr; const int col0 = u.pn * BM + wc * 32 + 8 * fq;
#pragma unroll
        for (int ai = 0; ai < 2; ++ai)
#pragma unroll
            for (int m = 0; m < 4; ++m) { bf16_t* rowp = O + (size_t)(row0 + ai * HALF + m * 16) * ldc + col0;
#pragma unroll
                for (int bj = 0; bj < 2; ++bj) { f32x4 v0 = acc[ai][bj][m][0], v1 = acc[ai][bj][m][1];
                    if (ACT == 1) {
#pragma unroll
                        for (int j = 0; j < 4; ++j) { const float a = fmaxf(v0[j], 0.f), b = fmaxf(v1[j], 0.f); v0[j] = a * a; v1[j] = b * b; } }
                    u32x4 w; w.x = cvt_pk_bf16(v0[0], v0[1]); w.y = cvt_pk_bf16(v0[2], v0[3]); w.z = cvt_pk_bf16(v1[0], v1[1]); w.w = cvt_pk_bf16(v1[2], v1[3]);
                    *(u32x4*)(rowp + bj * HALF) = w; } }
    }
};


struct EpiInEven { static constexpr int MIN_STORES = 0; static constexpr bool PERM = true, AFTER_DRAIN = false;
    static __device__ __forceinline__ int brow(int R) { const int wc = R >> 5, n = (R >> 4) & 1, fq = (R >> 2) & 3, i = R & 3; return (wc >> 1) * 128 + (wc & 1) * 64 + 8 * fq + 4 * n + i; }
    bf16_t* P; int ld; const float* rope  ; int rope_rows, seq;
    __device__ __forceinline__ void operator()(const f32x4 (&acc)[2][2][4][2], const Unit& u, int wr, int wc, int fr, int fq) const {
        const int row0 = u.pm * BM + wr * 64 + fr; const int col0 = u.pn * BM + (wc >> 1) * 128 + (wc & 1) * 64 + 8 * fq;
        const bool dorope = (u.pn >= 4 && u.pn <= 8) && (u.pm * BM < rope_rows);
#define EIE_STORE(a0_, a1_, b0_, b1_, rowp_) do { u32x4 w; w.x = cvt_pk_bf16(a0_[0], a0_[1]); w.y = cvt_pk_bf16(a0_[2], a0_[3]); w.z = cvt_pk_bf16(a1_[0], a1_[1]); w.w = cvt_pk_bf16(a1_[2], a1_[3]); *(u32x4*)(rowp_) = w; \
            w.x = cvt_pk_bf16(b0_[0], b0_[1]); w.y = cvt_pk_bf16(b0_[2], b0_[3]); w.z = cvt_pk_bf16(b1_[0], b1_[1]); w.w = cvt_pk_bf16(b1_[2], b1_[3]); *(u32x4*)((rowp_) + 32) = w; } while (0)
        if (!dorope) {
#pragma unroll
            for (int ai = 0; ai < 2; ++ai)
#pragma unroll
                for (int m = 0; m < 4; ++m) { bf16_t* rowp = P + (size_t)(row0 + ai * HALF + m * 16) * ld + col0;
                    EIE_STORE(acc[ai][0][m][0], acc[ai][0][m][1], acc[ai][1][m][0], acc[ai][1][m][1], rowp); }
        } else {
#define EIE_LD(idx, d0, d1, d2, d3) do { const int row_ = row0 + ((idx) >> 2) * HALF + ((idx) & 3) * 16; const int t_ = row_ & (seq - 1)  , pos_ = (wc & 1) ? (t_ & 63) : (t_ >> 6); \
                const f32x4* cs_ = (const f32x4*)(rope + ((size_t)pos_ * 32 + 8 * fq) * 2); d0 = cs_[0]; d1 = cs_[1]; d2 = cs_[2]; d3 = cs_[3]; } while (0)
            f32x4 n0, n1, n2, n3; EIE_LD(0, n0, n1, n2, n3);
#pragma unroll
            for (int idx = 0; idx < 8; ++idx) { const int ai = idx >> 2, m = idx & 3; bf16_t* rowp = P + (size_t)(row0 + ai * HALF + m * 16) * ld + col0;
                const f32x4 c0 = n0, c1 = n1, c2 = n2, c3 = n3;
                if (idx < 7) EIE_LD(idx + 1, n0, n1, n2, n3);
                const f32x4 a0 = acc[ai][0][m][0], a1 = acc[ai][0][m][1], b0 = acc[ai][1][m][0], b1 = acc[ai][1][m][1];
                f32x4 x0, x1, y0, y1;
                x0[0] = a0[0] * c0[0] - b0[0] * c0[1]; y0[0] = b0[0] * c0[0] + a0[0] * c0[1]; x0[1] = a0[1] * c0[2] - b0[1] * c0[3]; y0[1] = b0[1] * c0[2] + a0[1] * c0[3];
                x0[2] = a0[2] * c1[0] - b0[2] * c1[1]; y0[2] = b0[2] * c1[0] + a0[2] * c1[1]; x0[3] = a0[3] * c1[2] - b0[3] * c1[3]; y0[3] = b0[3] * c1[2] + a0[3] * c1[3];
                x1[0] = a1[0] * c2[0] - b1[0] * c2[1]; y1[0] = b1[0] * c2[0] + a1[0] * c2[1]; x1[1] = a1[1] * c2[2] - b1[1] * c2[3]; y1[1] = b1[1] * c2[2] + a1[1] * c2[3];
                x1[2] = a1[2] * c3[0] - b1[2] * c3[1]; y1[2] = b1[2] * c3[0] + a1[2] * c3[1]; x1[3] = a1[3] * c3[2] - b1[3] * c3[3]; y1[3] = b1[3] * c3[2] + a1[3] * c3[3];
                EIE_STORE(x0, x1, y0, y1, rowp); }
#undef EIE_LD
        }
#undef EIE_STORE
    } };


struct LinOrder { int nwg, G, c; __device__ __forceinline__ void init(int n, int G_, int c_) { nwg = n; G = G_; c = c_; }
    __device__ __forceinline__ bool nextL(int i, int& L) const { const long x = (long)i * G + c; if (x >= nwg) return false; L = (int)x; return true; }
    __device__ __forceinline__ void a_ready(const Unit&) const {} __device__ __forceinline__ void done(const Unit&) const {} };
struct SplitKSched : LinOrder { const char* A; const char* B; size_t rowpitch; int nN, Kc;
    __device__ __forceinline__ bool next(int i, Unit& u) const { int L; if (!nextL(i, L)) return false; u.pn = L % nN; const int q = L / nN; u.pm = q; return true; }
    __device__ __forceinline__ const char* a_ptr(const Unit& u) const { return A + (size_t)(u.pm & 1) * 256 * rowpitch + (size_t)(u.pm >> 1) * Kc * 2; }
    __device__ __forceinline__ const char* b_ptr(const Unit& u) const { return B + (size_t)u.pn * 256 * rowpitch + (size_t)(u.pm >> 1) * Kc * 2; }
    __device__ __forceinline__ const char* a_base() const { return A; } __device__ __forceinline__ const char* b_base() const { return B; } };
struct EpiSlab { static constexpr int MIN_STORES = 0; static constexpr bool PERM = false, AFTER_DRAIN = false; static __device__ __forceinline__ int brow(int R) { return R; }
    float* slab; int ldc;
    __device__ __forceinline__ void operator()(const f32x4 (&acc)[2][2][4][2], const Unit& u, int wr, int wc, int fr, int fq) const {
        const int row0 = (u.pm >> 1) * 512 + (u.pm & 1) * 256 + wr * 64 + fr, col0 = u.pn * BM + wc * 32 + 4 * fq;
#pragma unroll
        for (int ai = 0; ai < 2; ++ai)
#pragma unroll
            for (int m = 0; m < 4; ++m) { float* rowp = slab + (size_t)(row0 + ai * HALF + m * 16) * ldc + col0;
#pragma unroll
                for (int bj = 0; bj < 2; ++bj)
#pragma unroll
                    for (int n = 0; n < 2; ++n) *(f32x4*)(rowp + bj * HALF + n * 16) = acc[ai][bj][m][n]; }
    } };


struct EpiGate { static constexpr int MIN_STORES = 0; static constexpr bool PERM = true, AFTER_DRAIN = false; static __device__ __forceinline__ int brow(int R) { return (R & ~31) + perm32(R & 31); }
    bf16_t* Z; int ld;
    __device__ __forceinline__ void operator()(const f32x4 (&acc)[2][2][4][2], const Unit& u, int wr, int wc, int fr, int fq) const {
        const int row0 = u.pm * BM + wr * 64 + fr; const int col0 = u.pn * HALF + wc * 32 + 8 * fq;
#pragma unroll
        for (int ai = 0; ai < 2; ++ai)
#pragma unroll
            for (int m = 0; m < 4; ++m) { const f32x4 z0 = acc[ai][0][m][0] * acc[ai][1][m][0], z1 = acc[ai][0][m][1] * acc[ai][1][m][1];
                u32x4 w; w.x = cvt_pk_bf16(z0[0], z0[1]); w.y = cvt_pk_bf16(z0[2], z0[3]); w.z = cvt_pk_bf16(z1[0], z1[1]); w.w = cvt_pk_bf16(z1[2], z1[3]);
                *(u32x4*)(Z + (size_t)(row0 + ai * HALF + m * 16) * ld + col0) = w; }
    } };

struct FaCtxSched : LinOrder { const char* CM; const char* Pb; size_t pitchP;
    __device__ __forceinline__ bool next(int i, Unit& u) const { int L; if (!nextL(i, L)) return false; u.pm = L & 7; u.pn = L >> 3; return true; }
    __device__ __forceinline__ const char* a_ptr(const Unit& u) const { return CM + (size_t)(u.pm & 1) * 256 * 512; }
    __device__ __forceinline__ const char* b_ptr(const Unit& u) const { return Pb + (size_t)u.pn * 256 * pitchP + (size_t)(u.pm >> 1) * 512; }
    __device__ __forceinline__ const char* a_base() const { return CM; } __device__ __forceinline__ const char* b_base() const { return Pb; } };
struct FaCtxEpi { static constexpr int MIN_STORES = 0; static constexpr bool PERM = true, AFTER_DRAIN = false; static __device__ __forceinline__ int brow(int R) { return (R & ~31) + perm32(R & 31); } bf16_t* ZcCtx;
    __device__ __forceinline__ void operator()(const f32x4 (&acc)[2][2][4][2], const Unit& u, int wr, int wc, int fr, int fq) const {
        const int g = u.pm >> 1, ri = u.pm & 1, b = u.pn;
#pragma unroll
        for (int ai = 0; ai < 2; ++ai)
#pragma unroll
            for (int m = 0; m < 4; ++m) { const int j = 128 * ai + 64 * wr + 16 * m + fr;
#pragma unroll
                for (int bj = 0; bj < 2; ++bj) { const f32x4 v0 = acc[ai][bj][m][0], v1 = acc[ai][bj][m][1];
                    u32x4 w; w.x = cvt_pk_bf16(v0[0], v0[1]); w.y = cvt_pk_bf16(v0[2], v0[3]); w.z = cvt_pk_bf16(v1[0], v1[1]); w.w = cvt_pk_bf16(v1[2], v1[3]);
                    *(u32x4*)(ZcCtx + (((size_t)((b * 4 + g) * 256 + j) * 2 + ri) * 256 + 128 * bj + 32 * wc + 8 * fq)) = w; } }
    } };
struct FbSched : LinOrder { const char* A; const char* B;
    __device__ __forceinline__ bool next(int i, Unit& u) const { int L; if (!nextL(i, L)) return false; u.pm = 0; u.pn = L; return true; }
    __device__ __forceinline__ const char* a_ptr(const Unit&) const { return A; }
    __device__ __forceinline__ const char* b_ptr(const Unit& u) const { return B + (size_t)u.pn * 256 * 512; }
    __device__ __forceinline__ const char* a_base() const { return A; } __device__ __forceinline__ const char* b_base() const { return B; } };
typedef float f32x2v __attribute__((ext_vector_type(2)));
struct FbEpi { static constexpr int MIN_STORES = 0; static constexpr bool PERM = true, AFTER_DRAIN = false; static __device__ __forceinline__ int brow(int R) { return (R & ~31) + perm32(R & 31); } bf16_t* A1c; const f32x2v* w16k;
    __device__ __forceinline__ void operator()(const f32x4 (&acc)[2][2][4][2], const Unit& u, int wr, int wc, int fr, int fq) const {
        const int t20 = 32 * wc + 8 * fq;
#pragma unroll
        for (int m = 0; m < 4; ++m) { const int k1 = 64 * wr + 16 * m + fr; const f32x2v t0 = w16k[(k1 * t20) & 16383], st = w16k[k1];
            bf16_t* dst0 = A1c + (((size_t)u.pn * 2 * 128 + k1) * 2) * 128 + t20; bf16_t* dst1 = dst0 + (size_t)128 * 2 * 128;
            float cx = t0.x, cy = t0.y; u32x4 wr0, wi0, wr1, wi1; float pr0 = 0.f, pi0 = 0.f, pr1 = 0.f, pi1 = 0.f;
#pragma unroll
            for (int e = 0; e < 8; ++e) { const float ar0 = acc[0][0][m][e >> 2][e & 3], ai0 = acc[1][0][m][e >> 2][e & 3], ar1 = acc[0][1][m][e >> 2][e & 3], ai1 = acc[1][1][m][e >> 2][e & 3];
                const float br0 = ar0 * cx + ai0 * cy, bi0 = ai0 * cx - ar0 * cy, br1 = ar1 * cx + ai1 * cy, bi1 = ai1 * cx - ar1 * cy;
                if (e & 1) { wr0[e >> 1] = cvt_pk_bf16(pr0, br0); wi0[e >> 1] = cvt_pk_bf16(pi0, bi0); wr1[e >> 1] = cvt_pk_bf16(pr1, br1); wi1[e >> 1] = cvt_pk_bf16(pi1, bi1); }
                else { pr0 = br0; pi0 = bi0; pr1 = br1; pi1 = bi1; }
                const float nx = cx * st.x - cy * st.y, ny = cx * st.y + cy * st.x; cx = nx; cy = ny; }
            *(u32x4*)dst0 = wr0; *(u32x4*)(dst0 + 128) = wi0; *(u32x4*)dst1 = wr1; *(u32x4*)(dst1 + 128) = wi1;
            asm volatile("" ::: "memory"); }
    } };
struct FcSched : LinOrder { const char* A; const char* B;
    __device__ __forceinline__ bool next(int i, Unit& u) const { int L; if (!nextL(i, L)) return false; u.pm = L & 127; u.pn = L >> 7; return true; }
    __device__ __forceinline__ const char* a_ptr(const Unit&) const { return A; }
    __device__ __forceinline__ const char* b_ptr(const Unit& u) const { return B + ((size_t)u.pn * 256 * 128 + u.pm) * 512; }
    __device__ __forceinline__ const char* a_base() const { return A; } __device__ __forceinline__ const char* b_base() const { return B; } };
struct CtxSched : LinOrder { const char* A; const char* B;
    __device__ __forceinline__ bool next(int i, Unit& u) const { int L; if (!nextL(i, L)) return false; u.pm = 0; u.pn = L; return true; }
    __device__ __forceinline__ const char* a_ptr(const Unit&) const { return A; }
    __device__ __forceinline__ const char* b_ptr(const Unit& u) const { return B + (size_t)u.pn * 256 * 1024; }
    __device__ __forceinline__ const char* a_base() const { return A; } __device__ __forceinline__ const char* b_base() const { return B; } };
struct CtxDftEpi { static constexpr int MIN_STORES = 0; static constexpr bool PERM = true, AFTER_DRAIN = false; static __device__ __forceinline__ int brow(int R) { return (R & ~31) + perm32(R & 31); } bf16_t* MIXp; int row0, ld;
    __device__ __forceinline__ void operator()(const f32x4 (&acc)[2][2][4][2], const Unit& u, int wr, int wc, int fr, int fq) const {
        const int b = u.pn >> 2, g = u.pn & 3;
#pragma unroll
        for (int ai = 0; ai < 2; ++ai)
#pragma unroll
            for (int m = 0; m < 4; ++m) { const int k = 128 * ai + 64 * wr + 16 * m + fr; bf16_t* rowp = MIXp + ((size_t)row0 + b * 256 + k) * ld + g * 256;
#pragma unroll
                for (int bj = 0; bj < 2; ++bj) { const f32x4 v0 = acc[ai][bj][m][0] * (1.0f / 256.0f), v1 = acc[ai][bj][m][1] * (1.0f / 256.0f); const int j0 = 128 * bj + 32 * wc + 8 * fq;
                    u32x4 w; w.x = cvt_pk_bf16(v0[0], v0[1]); w.y = cvt_pk_bf16(v0[2], v0[3]); w.z = cvt_pk_bf16(v1[0], v1[1]); w.w = cvt_pk_bf16(v1[2], v1[3]);
                    if (bj == 0) *(u32x4*)(rowp + j0) = w;
                    else {
#pragma unroll
                        for (int e = 0; e < 8; ++e) { const int c = j0 + e, sl = c == 128 ? 128 : 384 - c; const unsigned ww = e < 2 ? w.x : (e < 4 ? w.y : (e < 6 ? w.z : w.w)); rowp[sl] = (bf16_t)((e & 1) ? (ww >> 16) : (ww & 0xffffu)); } } } }
    } };


struct FaHSched : LinOrder { const char* CM; const char* Pb; size_t pitchP; int seq;
    __device__ __forceinline__ bool next(int i, Unit& u) const { int L; if (!nextL(i, L)) return false; u.pm = L & 3; u.pn = L >> 2; return true; }
    __device__ __forceinline__ const char* a_ptr(const Unit&) const { return CM; }
    __device__ __forceinline__ const char* b_ptr(const Unit& u) const { const int b = u.pn >> 6, t2 = 2 * (u.pn & 63); return Pb + ((size_t)b * seq + t2) * pitchP + (size_t)u.pm * 512; }
    __device__ __forceinline__ const char* a_base() const { return CM; } __device__ __forceinline__ const char* b_base() const { return Pb; } };
struct FaHEpi { static constexpr int MIN_STORES = 0; static constexpr bool PERM = true, AFTER_DRAIN = false; static __device__ __forceinline__ int brow(int R) { return (R & ~31) + perm32(R & 31); } bf16_t* Zc;
    __device__ __forceinline__ void operator()(const f32x4 (&acc)[2][2][4][2], const Unit& u, int wr, int wc, int fr, int fq) const {
        const int g = u.pm, b = u.pn >> 6, t2p = 2 * (u.pn & 63), bg = b * 4 + g;
#pragma unroll
        for (int ai = 0; ai < 2; ++ai)
#pragma unroll
            for (int m = 0; m < 4; ++m) { const int j = 64 * wr + 16 * m + fr;
#pragma unroll
                for (int bj = 0; bj < 2; ++bj) { const f32x4 v0 = acc[ai][bj][m][0], v1 = acc[ai][bj][m][1];
                    u32x4 w; w.x = cvt_pk_bf16(v0[0], v0[1]); w.y = cvt_pk_bf16(v0[2], v0[3]); w.z = cvt_pk_bf16(v1[0], v1[1]); w.w = cvt_pk_bf16(v1[2], v1[3]);
                    const size_t t2 = (size_t)(t2p + bj), t10 = 32 * wc + 8 * fq;
                    if (ai == 1 && j == 0) {
                        const u32x4 z = {0u, 0u, 0u, 0u};
                        *(u32x4*)(Zc + ((((size_t)(1024 + bg) * 128 + t2) * 2 + 0) * 128 + t10)) = w; *(u32x4*)(Zc + ((((size_t)(1024 + bg) * 128 + t2) * 2 + 1) * 128 + t10)) = z;
                        *(u32x4*)(Zc + ((((size_t)(bg * 128) * 128 + t2) * 2 + 1) * 128 + t10)) = z;
                    } else *(u32x4*)(Zc + ((((size_t)(bg * 128 + j) * 128 + t2) * 2 + ai) * 128 + t10)) = w; } }
    } };
struct FcHEpi { static constexpr int MIN_STORES = 0; static constexpr bool PERM = true, AFTER_DRAIN = false; static __device__ __forceinline__ int brow(int R) { return (R & ~31) + perm32(R & 31); } bf16_t* MIXp; int seq, ld;
    __device__ __forceinline__ void operator()(const f32x4 (&acc)[2][2][4][2], const Unit& u, int wr, int wc, int fr, int fq) const {
        const int k1 = u.pm;
#pragma unroll
        for (int m = 0; m < 4; ++m) { const int k2 = 64 * wr + 16 * m + fr, k = k1 + 128 * k2, km = (seq - k) & (seq - 1);
            if (u.pn < 4) {
#pragma unroll
                for (int bj = 0; bj < 2; ++bj) { const int bg = 2 * u.pn + bj, b = bg >> 2, g = bg & 3, j0 = 32 * wc + 8 * fq;
                    const f32x4 v0 = acc[0][bj][m][0] * (1.0f / 2048.0f), v1 = acc[0][bj][m][1] * (1.0f / 2048.0f);
                    u32x4 w; w.x = cvt_pk_bf16(v0[0], v0[1]); w.y = cvt_pk_bf16(v0[2], v0[3]); w.z = cvt_pk_bf16(v1[0], v1[1]); w.w = cvt_pk_bf16(v1[2], v1[3]);
                    *(u32x4*)(MIXp + ((size_t)b * seq + k) * ld + g * 256 + j0) = w;
                    bf16_t* mp = MIXp + ((size_t)b * seq + km) * ld + g * 256 + 128 + j0;
                    if (j0 != 0) *(u32x4*)mp = w;
                    else { mp[1] = (bf16_t)(w.x >> 16); *(unsigned*)(mp + 2) = w.y; *(unsigned long long*)(mp + 4) = ((unsigned long long)w.w << 32) | w.z; } }
            } else if (wc == 0 && fq == 0) {
                const f32x4 v0 = acc[0][0][m][0] * (1.0f / 2048.0f), v1 = acc[0][0][m][1] * (1.0f / 2048.0f);
#pragma unroll
                for (int e = 0; e < 8; ++e) { const float y = e < 4 ? v0[e & 3] : v1[e & 3]; MIXp[((size_t)(e >> 2) * seq + k) * ld + (e & 3) * 256 + 128] = (bf16_t)(cvt_pk_bf16(y, 0.f) & 0xffffu); }
            } }
    } };

template <class Epi, class Sched, bool ALIGN_EPI = false, bool SP2 = false>
__device__ __forceinline__ void gemm_phase(PG8_LAS unsigned char* lds, const Gemm g, const Sched& S, const Epi& E, const int tid) {
    const int wid = __builtin_amdgcn_readfirstlane(tid >> 6), lane = tid & 63, wr = wid >> 2, wc = wid & 3, fr = lane & 15, fq = lane >> 4;
    int Kl = g.K; asm volatile("" : "+s"(Kl));
    const int nt = Kl / BK;
    unsigned voffA[2], voffB[2];
#pragma unroll
    for (int i = 0; i < 2; ++i) { int R, C; stage_rc(tid * 16 + i * 8192, R, C); const int Rb = Epi::brow(R);
        voffA[i] = (unsigned)R * g.pitchA + (unsigned)C * 2u; voffB[i] = (unsigned)Rb * g.pitchB + (unsigned)C * 2u; }
    const unsigned kstep = (unsigned)(BK * 2);
    const unsigned hstepA = (unsigned)g.hstepA, hstepB = (unsigned)g.hstepB;
    const char* const baseA = S.a_base(); const char* const baseB = S.b_base();
    const __amdgpu_buffer_rsrc_t rs_voffA = __builtin_amdgcn_make_buffer_rsrc((void*)baseA, 0, 0x7fffffff, 0x00020000);
    const __amdgpu_buffer_rsrc_t rs_voffB = __builtin_amdgcn_make_buffer_rsrc((void*)baseB, 0, 0x7fffffff, 0x00020000);
    const unsigned ldsw = (unsigned)wid * 1024u;
    const int aoff = lds_byte(wr * 64 + fr, fq * 8), boff = lds_byte(wc * 32 + fr, fq * 8);
#define PG8_SA(b, h) (((b) * 2 + (h)) * HTB)
#define PG8_SB(b, h) ((4 + (b) * 2 + (h)) * HTB)
#define PG8_STAGE(bufoff, goff, voff) do { _Pragma("unroll") for (int _i = 0; _i < 2; ++_i) \
        __builtin_amdgcn_raw_ptr_buffer_load_lds(rs_##voff, (PG8_LAS unsigned*)(lds + (bufoff) + ldsw + _i * 8192), 16, (voff)[_i], (goff), 0, 0); } while (0)
#define PG8_LDA(dst, b, h) do { _Pragma("unroll") for (int m = 0; m < 4; ++m) _Pragma("unroll") for (int k = 0; k < 2; ++k) dst[m][k] = *(const PG8_LAS bf16x8*)(lds + PG8_SA(b, h) + aoff + m * 2048 + k * 1024); } while (0)
#define PG8_LDB(dst, b, h) do { _Pragma("unroll") for (int n = 0; n < 2; ++n) _Pragma("unroll") for (int k = 0; k < 2; ++k) dst[n][k] = *(const PG8_LAS bf16x8*)(lds + PG8_SB(b, h) + boff + n * 2048 + k * 1024); } while (0)
#define PG8_MMA(ai, bj, At, Bt) do { __builtin_amdgcn_s_setprio(1); _Pragma("unroll") for (int m = 0; m < 4; ++m) _Pragma("unroll") for (int n = 0; n < 2; ++n) _Pragma("unroll") for (int k = 0; k < 2; ++k) \
        acc[ai][bj][m][n] = __builtin_amdgcn_mfma_f32_16x16x32_bf16(Bt[n][k], At[m][k], acc[ai][bj][m][n], 0, 0, 0); __builtin_amdgcn_s_setprio(0); } while (0)
#define PG8_WAIT_V(n) asm volatile("s_waitcnt vmcnt(" #n ")" ::: "memory")
#define PG8_WAIT_L(n) asm volatile("s_waitcnt lgkmcnt(" #n ")" ::: "memory")
#define PG8_BAR __builtin_amdgcn_s_barrier()
#define PG8_SCHED __builtin_amdgcn_sched_barrier(0)
    Unit cur, nxt; int ui = 0;
    if (!S.next(0, cur)) return;
    f32x4 acc[2][2][4][2];
#pragma unroll
    for (int a = 0; a < 2; ++a)
#pragma unroll
        for (int b = 0; b < 2; ++b)
#pragma unroll
            for (int m = 0; m < 4; ++m)
#pragma unroll
                for (int n = 0; n < 2; ++n) acc[a][b][m][n] = (f32x4){0.f, 0.f, 0.f, 0.f};
    bf16x8 At[4][2], B0[2][2], B1[2][2];
    unsigned cA = (unsigned)(S.a_ptr(cur) - baseA), cB = (unsigned)(S.b_ptr(cur) - baseB);
    S.a_ready(cur);
    if constexpr (SP2) {
        PG8_STAGE(PG8_SB(0, 0), cB, voffB); PG8_STAGE(PG8_SB(0, 1), cB + hstepB, voffB); PG8_STAGE(PG8_SA(0, 0), cA, voffA); PG8_STAGE(PG8_SA(0, 1), cA + hstepA, voffA);
        if (wr == 1) PG8_BAR;
        PG8_WAIT_V(2); PG8_BAR;
        PG8_STAGE(PG8_SB(1, 0), cB + kstep, voffB); PG8_STAGE(PG8_SA(1, 0), cA + kstep, voffA); PG8_STAGE(PG8_SB(1, 1), cB + hstepB + kstep, voffB);
        PG8_WAIT_V(6); PG8_BAR;
    } else {
        PG8_STAGE(PG8_SB(0, 0), cB, voffB); PG8_STAGE(PG8_SA(0, 0), cA, voffA); PG8_STAGE(PG8_SB(0, 1), cB + hstepB, voffB); PG8_STAGE(PG8_SA(0, 1), cA + hstepA, voffA);
        if (wr == 1) PG8_BAR;
        PG8_WAIT_V(4); PG8_BAR;
        PG8_STAGE(PG8_SB(1, 0), cB + kstep, voffB); PG8_STAGE(PG8_SA(1, 0), cA + kstep, voffA); PG8_STAGE(PG8_SB(1, 1), cB + hstepB + kstep, voffB);
        PG8_WAIT_V(6); PG8_BAR;
    }
    for (;;) {
        const bool has_next = S.next(ui + 1, nxt);
        const unsigned nA = has_next ? (unsigned)(S.a_ptr(nxt) - baseA) : cA, nB = has_next ? (unsigned)(S.b_ptr(nxt) - baseB) : cB;
        for (int t = 0; t < nt; t += 2) {
            const bool last = (t == nt - 2);
            const unsigned a1 = cA + (unsigned)(t + 1) * kstep;
            const unsigned a2 = last ? nA : cA + (unsigned)(t + 2) * kstep, b2 = last ? nB : cB + (unsigned)(t + 2) * kstep;
            const unsigned a3 = a2 + kstep, b3 = b2 + kstep;
            if (last && has_next) S.a_ready(nxt);
            if constexpr (SP2) {
            const bool relax = Epi::MIN_STORES >= 16 && ui > 0 && t == 0;
            PG8_LDB(B0, 0, 0); PG8_LDB(B1, 0, 1); PG8_SCHED; PG8_LDA(At, 0, 0); PG8_STAGE(PG8_SA(1, 1), a1 + hstepA, voffA);
            if (relax) PG8_WAIT_V(24); else PG8_WAIT_V(8);
            PG8_WAIT_L(0); PG8_BAR; PG8_MMA(0, 0, At, B0); PG8_MMA(0, 1, At, B1); PG8_BAR; PG8_SCHED;
            PG8_LDA(At, 0, 1); PG8_STAGE(PG8_SB(0, 0), b2, voffB); PG8_STAGE(PG8_SB(0, 1), b2 + hstepB, voffB); PG8_STAGE(PG8_SA(0, 0), a2, voffA);
            if (relax) PG8_WAIT_V(24); else PG8_WAIT_V(8);
            PG8_WAIT_L(0); PG8_BAR; PG8_MMA(1, 0, At, B0); PG8_MMA(1, 1, At, B1); PG8_BAR; PG8_SCHED;
            PG8_LDB(B0, 1, 0); PG8_LDB(B1, 1, 1); PG8_SCHED; PG8_LDA(At, 1, 0); PG8_STAGE(PG8_SA(0, 1), a2 + hstepA, voffA);
            PG8_WAIT_V(8); PG8_WAIT_L(0); PG8_BAR; PG8_MMA(0, 0, At, B0); PG8_MMA(0, 1, At, B1); PG8_BAR; PG8_SCHED;
            PG8_LDA(At, 1, 1); PG8_STAGE(PG8_SB(1, 0), b3, voffB); PG8_STAGE(PG8_SB(1, 1), b3 + hstepB, voffB); PG8_STAGE(PG8_SA(1, 0), a3, voffA);
            PG8_WAIT_V(8); PG8_WAIT_L(0); PG8_BAR; PG8_MMA(1, 0, At, B0); PG8_MMA(1, 1, At, B1); PG8_BAR; PG8_SCHED;
            } else {
            PG8_LDB(B0, 0, 0); PG8_SCHED; PG8_LDA(At, 0, 0); PG8_STAGE(PG8_SA(1, 1), a1 + hstepA, voffA);
            PG8_WAIT_L(8); PG8_BAR; PG8_WAIT_L(0); PG8_MMA(0, 0, At, B0); PG8_BAR; PG8_SCHED;
            PG8_LDB(B1, 0, 1); PG8_STAGE(PG8_SB(0, 0), b2, voffB);
            PG8_BAR; PG8_WAIT_L(0); PG8_MMA(0, 1, At, B1); PG8_BAR;
            PG8_LDA(At, 0, 1); PG8_STAGE(PG8_SA(0, 0), a2, voffA);
            PG8_BAR; PG8_WAIT_L(0); PG8_MMA(1, 0, At, B0); PG8_BAR; PG8_SCHED;
            PG8_STAGE(PG8_SB(0, 1), b2 + hstepB, voffB);
            PG8_WAIT_V(6); PG8_BAR; PG8_MMA(1, 1, At, B1); PG8_BAR;
            PG8_LDB(B0, 1, 0); PG8_SCHED; PG8_LDA(At, 1, 0); PG8_STAGE(PG8_SA(0, 1), a2 + hstepA, voffA);
            PG8_WAIT_L(8); PG8_BAR; PG8_WAIT_L(0); PG8_MMA(0, 0, At, B0); PG8_BAR; PG8_SCHED;
            PG8_LDB(B1, 1, 1); PG8_STAGE(PG8_SB(1, 0), b3, voffB);
            PG8_BAR; PG8_WAIT_L(0); PG8_MMA(0, 1, At, B1); PG8_BAR;
            PG8_LDA(At, 1, 1); PG8_STAGE(PG8_SA(1, 0), a3, voffA);
            PG8_BAR; PG8_WAIT_L(0); PG8_MMA(1, 0, At, B0); PG8_BAR; PG8_SCHED;
            PG8_STAGE(PG8_SB(1, 1), b3 + hstepB, voffB);
            PG8_WAIT_V(6); PG8_BAR; PG8_MMA(1, 1, At, B1); PG8_BAR;
            }
        }
        if constexpr (ALIGN_EPI) { if (wr == 0) PG8_BAR; }
        if constexpr (!Epi::AFTER_DRAIN) { E(acc, cur, wr, wc, fr, fq); S.done(cur); }
        if (!has_next) break;
#pragma unroll
        for (int a = 0; a < 2; ++a)
#pragma unroll
            for (int b = 0; b < 2; ++b)
#pragma unroll
                for (int m = 0; m < 4; ++m)
#pragma unroll
                    for (int n = 0; n < 2; ++n) acc[a][b][m][n] = (f32x4){0.f, 0.f, 0.f, 0.f};
        cur = nxt; cA = nA; cB = nB; ++ui;
        if constexpr (ALIGN_EPI) { if (wr == 1) PG8_BAR; }
    }
    PG8_WAIT_V(0);
    if constexpr (!ALIGN_EPI) { if (wr == 0) PG8_BAR; }
    PG8_BAR;
#undef PG8_SA
#undef PG8_SB
#undef PG8_STAGE
#undef PG8_LDA
#undef PG8_LDB
#undef PG8_MMA
#undef PG8_WAIT_V
#undef PG8_WAIT_L
#undef PG8_BAR
#undef PG8_SCHED
}
}

#define PG8_SP2 true
#define PG8_ALIGN true

constexpr int NWAVES = 8;
constexpr int D = 2048, SEQ = 16384, NBATCH = 2, M_TOK = NBATCH * SEQ, CTXL = 256, M_CTX = NBATCH * CTXL, MT = M_TOK + M_CTX, DEPTH = 4;
constexpr int FF = 8192, EIN = 2560, OIN = 6144, NMODV = 6 * D;
constexpr float NORM_EPS = 1e-6f;
constexpr float ATTN_SCALE = 0.08838834764831845f;

constexpr size_t MiB = 1u << 20;
constexpr size_t WS_CTL = 0, CTL_ZERO_BYTES = 1 * MiB;
constexpr size_t WS_MOD = 1 * MiB;
constexpr size_t WS_ROPE = 2 * MiB;
constexpr size_t WS_W16K = 2 * MiB + 128 * 1024;
constexpr size_t WS_DFT = 3 * MiB;
constexpr size_t DFT_CM = 0, DFT_FB1 = 512 * 256 * 2, DFT_FC2 = DFT_FB1 + 256 * 256 * 2, DFT_F256 = DFT_FC2 + 256 * 256 * 2, DFT_CMH = DFT_F256 + 256 * 512 * 2;
constexpr size_t WS_XC = 4 * MiB;
constexpr size_t WS_WIN_E = 8 * MiB;
constexpr size_t WS_WOUT_E = 28 * MiB;
constexpr size_t WS_WIN_O = 44 * MiB;
constexpr size_t WS_WOUT_O = 92 * MiB;
constexpr size_t WS_W1 = 108 * MiB;
constexpr size_t WS_W2 = 236 * MiB;
constexpr size_t WS_XB = 364 * MiB;
constexpr size_t WS_MO = 494 * MiB;
constexpr size_t WS_BIG = 624 * MiB;
constexpr size_t WS_H = WS_BIG;
constexpr size_t WS_P = WS_BIG;
constexpr size_t WS_Z = WS_BIG + 164 * MiB;
constexpr size_t WS_A1 = WS_BIG + 296 * MiB;
constexpr size_t WS_ZCTX = WS_BIG + 428 * MiB;
constexpr size_t WS_G = WS_BIG;
constexpr size_t WS_ZG = WS_BIG + 130 * MiB;
constexpr size_t WS_AC = WS_BIG + 390 * MiB;
constexpr size_t WS_CSP = WS_BIG + 520 * MiB;
constexpr size_t WS_END = WS_CSP + 64 * MiB;
constexpr int CW_BAR = 4096;

constexpr int RING_OFF = 0, RING_BYTES = 131072;
constexpr int LDSCTL_OFF = RING_BYTES, MISC_OFF = LDSCTL_OFF + 320;
constexpr int LDS_BYTES = 147456;

#define GAS __attribute__((address_space(1)))
#define LAS __attribute__((address_space(3)))
typedef unsigned short bf16;
typedef unsigned v4u __attribute__((ext_vector_type(4)));
typedef unsigned v2u __attribute__((ext_vector_type(2)));
typedef float f32x4 __attribute__((ext_vector_type(4)));
typedef float f32x2 __attribute__((ext_vector_type(2)));
typedef GAS unsigned gu32;
#define RLX_AGENT __ATOMIC_RELAXED, __HIP_MEMORY_SCOPE_AGENT
#define LDS_WAIT() asm volatile("s_waitcnt lgkmcnt(0)" ::: "memory")
#define VM_WAIT() asm volatile("s_waitcnt vmcnt(0)" ::: "memory")
__device__ __forceinline__ unsigned pk2(float lo, float hi) { return pg8::cvt_pk_bf16(lo, hi); }
__device__ __forceinline__ float bflo(unsigned v) { return __uint_as_float(v << 16); }
__device__ __forceinline__ float bfhi(unsigned v) { return __uint_as_float(v & 0xffff0000u); }

#define XB_TMO      128
#define XB_XCNT(j)  (256  + 64 * (j))
#define XB_XSUB(j)  (1280 + 64 * (j))
#define XB_XGEN(j)  (2304 + 64 * (j))
#define XB_TOP      3328
#define XB_TOPGEN   3392
#define XCD_BAR_WORDS 3456
#define XB_SPIN_CAP (1u << 22)
__device__ __forceinline__ unsigned xb_ld(unsigned* p)              { return __hip_atomic_load(p, __ATOMIC_RELAXED, __HIP_MEMORY_SCOPE_AGENT); }
__device__ __forceinline__ unsigned xb_add(unsigned* p, unsigned v) { return __hip_atomic_fetch_add(p, v, __ATOMIC_RELAXED, __HIP_MEMORY_SCOPE_AGENT); }
__device__ __forceinline__ unsigned xb_xcc_id() { return (unsigned)__builtin_amdgcn_s_getreg((3 << 11) | 20) & 0xFu; }
#define XB_SPIN(cond, bar) do { unsigned _sp = 0; while (cond) { __builtin_amdgcn_s_sleep(1); \
    if ((++_sp & 255u) == 0u) { if (xb_ld(&(bar)[XB_TMO])) break; if (_sp > XB_SPIN_CAP) { atomicAdd(&(bar)[XB_TMO], 1u); break; } } } } while (0)
struct XcdBarrier { unsigned* bar; unsigned x; volatile LAS unsigned* st; };
__device__ __forceinline__ XcdBarrier xcd_barrier_post(unsigned* bar, volatile LAS unsigned* st) {
    XcdBarrier b; b.bar = bar; b.x = xb_xcc_id(); b.st = st;
    if (threadIdx.x == 0) (void)xb_add(&bar[XB_XCNT(b.x)], 1u);
    return b;
}
__device__ __forceinline__ void xcd_barrier_complete(unsigned* bar, unsigned x, unsigned& nloc, unsigned& nx) {
    const unsigned G = gridDim.x * gridDim.y * gridDim.z;
    unsigned sum, cnt, mine, sp = 0u;
    for (;;) {
        sum = 0u; cnt = 0u; mine = 0u;
#pragma unroll
        for (unsigned j = 0; j < 16; ++j) { const unsigned c = xb_ld(&bar[XB_XCNT(j)]); sum += c; cnt += (c > 0u) ? 1u : 0u; mine = (j == x) ? c : mine; }
        if (sum == G) break;
        __builtin_amdgcn_s_sleep(1);
        if ((++sp & 255u) == 0u) { if (xb_ld(&bar[XB_TMO])) break; if (sp > XB_SPIN_CAP) { atomicAdd(&bar[XB_TMO], 1u); break; } }
    }
    nloc = mine > 0u ? mine : 1u; nx = cnt > 0u ? cnt : 1u;
}
__device__ __forceinline__ void xcd_barrier(const XcdBarrier& b) {
    asm volatile("s_waitcnt vmcnt(0)" ::: "memory");
    __syncthreads();
    if (threadIdx.x == 0) {
        unsigned* bar = b.bar;
        __builtin_amdgcn_s_waitcnt(0);
        unsigned nloc = b.st[0], nx = b.st[1];
        if (nloc == 0u) { xcd_barrier_complete(bar, b.x, nloc, nx); b.st[0] = nloc; b.st[1] = nx; }
        const unsigned old = xb_add(&bar[XB_XSUB(b.x)], 1u);
        const unsigned gen = old / nloc;
        if (old + 1u == (gen + 1u) * nloc) {
            __builtin_amdgcn_fence(__ATOMIC_RELEASE, "agent");
            asm volatile("s_waitcnt vmcnt(0)" ::: "memory");
            const unsigned og = xb_add(&bar[XB_TOP], 1u);
            const unsigned tg = og / nx;
            if (og + 1u == (tg + 1u) * nx) xb_add(&bar[XB_TOPGEN], 1u);
            else XB_SPIN(xb_ld(&bar[XB_TOPGEN]) == tg, bar);
            __builtin_amdgcn_fence(__ATOMIC_ACQUIRE, "agent");
            xb_add(&bar[XB_XGEN(b.x)], 1u);
            asm volatile("s_waitcnt vmcnt(0)" ::: "memory");
        } else {
            XB_SPIN(xb_ld(&bar[XB_XGEN(b.x)]) == gen, bar);
            __builtin_amdgcn_fence(__ATOMIC_ACQUIRE, "agent");
            asm volatile("s_waitcnt vmcnt(0)" ::: "memory");
        }
    }
    __syncthreads();
}

struct Frame {
    LAS unsigned char* lds;
    volatile LAS unsigned* MISC;
    gu32* ctl;
    int tid, lane, wave, G, bid;
    const float *x, *c, *ctx, *c_ctx, *w_mod, *b_mod, *gains, *att_w_in, *att_sink, *att_w_out, *conv_w_in, *conv_w, *conv_w_out, *mlp_w1, *mlp_w2;
    float* out; unsigned char* ws;
};

__device__ __forceinline__ float shfl_xor_l(float v, int mask, int lane) { return __int_as_float(__builtin_amdgcn_ds_bpermute((lane ^ mask) << 2, __float_as_int(v))); }
__device__ __forceinline__ float wave_sum_l(float v, int  ) {
#define WS_DPP(ctrl, rmask, bc) __int_as_float(__builtin_amdgcn_update_dpp(0, __float_as_int(v), (ctrl), (rmask), 0xf, (bc)))
    v += WS_DPP(0x111, 0xf, true); v += WS_DPP(0x112, 0xf, true); v += WS_DPP(0x114, 0xf, true); v += WS_DPP(0x118, 0xf, true);
    v += WS_DPP(0x142, 0xa, false);
    v += WS_DPP(0x143, 0xc, false);
#undef WS_DPP
    return __int_as_float(__builtin_amdgcn_readlane(__float_as_int(v), 63));
}
__device__ __forceinline__ float wave_max_l(float v, int lane) {
#pragma unroll
    for (int o = 1; o < 64; o <<= 1) v = fmaxf(v, shfl_xor_l(v, o, lane));
    return v;
}
#define wave_sum(v) wave_sum_l((v), F.lane)
#define wave_max(v) wave_max_l((v), F.lane)

__device__ __forceinline__ void dsincos_small(double r, double& s, double& c) {
    const double r2 = r * r; double ts = 1.0, tc = 1.0, ss = 1.0, cs = 1.0;
#pragma unroll
    for (int n = 1; n <= 11; ++n) { tc *= -r2 * (1.0 / (double)((2 * n - 1) * (2 * n))); cs += tc; ts *= -r2 * (1.0 / (double)((2 * n) * (2 * n + 1))); ss += ts; }
    s = r * ss; c = cs;
}
__device__ __forceinline__ void unit_root(int p, float& co, float& si) {
    const int quad = p >> 12; int rem = p & 4095; bool sw = false;
    if (rem > 2048) { rem = 4096 - rem; sw = true; }
    double s, c; dsincos_small((double)rem * (6.283185307179586476925 / 16384.0), s, c);
    if (sw) { const double t = s; s = c; c = t; }
    double cc = (quad & 1) ? -s : c, sn = (quad & 1) ? c : s;
    if (quad & 2) { cc = -cc; sn = -sn; }
    co = (float)cc; si = (float)sn;
}

__device__ __forceinline__ int four_slot_channel(int k) { const int s_ = k & 255; return k < 1024 ? (k & ~255) + (s_ <= 128 ? s_ : 384 - s_) : k; }
template <bool KPERM = false>
__device__ __forceinline__ void p0_transpose_item(const float* W, int K, int N, bf16* WT, LAS float* scr, int item, int lane) {
    const int nblk = N / 32, kb = item / nblk, nb = item % nblk, k0 = 64 * kb, n0 = 32 * nb;
#pragma unroll 8
    for (int i = 0; i < 32; ++i) { const int kk = 2 * i + (lane >> 5); const int ks = KPERM ? four_slot_channel(k0 + kk) : k0 + kk; scr[kk * 33 + (lane & 31)] = W[(size_t)ks * N + n0 + (lane & 31)]; }
    LDS_WAIT(); asm volatile("" ::: "memory");
    const int c = lane & 7;
#pragma unroll
    for (int j = 0; j < 4; ++j) { const int n = (lane >> 3) + 8 * j; const LAS float* s = scr + (8 * c) * 33 + n;
        v4u o; o.x = pk2(s[0 * 33], s[1 * 33]); o.y = pk2(s[2 * 33], s[3 * 33]); o.z = pk2(s[4 * 33], s[5 * 33]); o.w = pk2(s[6 * 33], s[7 * 33]);
        *(v4u*)(WT + (size_t)(n0 + n) * K + k0 + 8 * c) = o; }
    LDS_WAIT(); asm volatile("" ::: "memory");
}

__device__ __forceinline__ float silu_f(float v) { return v / (1.0f + expf(-v)); }

__device__ __forceinline__ void p0_prologue(Frame& F) {
    const int gt = F.bid * 512 + F.tid, NT = F.G * 512;
    {
        f32x2* rope = (f32x2*)(F.ws + WS_ROPE); f32x2* w16k = (f32x2*)(F.ws + WS_W16K);
        for (int i = gt; i < 16384; i += NT) { float co, si; unit_root(i, co, si); w16k[i] = (f32x2){co, si}; }
        for (int i = gt; i < 256 * 32; i += NT) {
            const int pos = i >> 5, fi = i & 31;
            const double s3 = sqrt(sqrt(sqrt(0.1)));
            double f = 1.0; for (int k = 0; k < fi; ++k) f *= s3;
            const float invf = (float)f; const float af = (float)pos * invf;
            const double a = (double)af; const double kq = rint(a * 0.63661977236758134308);
            const double r = (a - kq * 1.57079632679489655800) - kq * 6.123233995736766036e-17;
            double s, c; dsincos_small(r, s, c); const int q = ((int)kq) & 3; double cc = (q & 1) ? -s : c, sn = (q & 1) ? c : s;
            if (q & 2) { cc = -cc; sn = -sn; }
            rope[i] = (f32x2){(float)cc, (float)sn};
        }
    }
    {
            bf16* cm = (bf16*)(F.ws + WS_DFT + DFT_CM); bf16* fb1 = (bf16*)(F.ws + WS_DFT + DFT_FB1); bf16* fc2 = (bf16*)(F.ws + WS_DFT + DFT_FC2); bf16* f256 = (bf16*)(F.ws + WS_DFT + DFT_F256);
            for (int i = gt; i < 512 * 256; i += NT) { const int row = i >> 8, c = i & 255, ri = row >> 8, j = row & 255; float co, si; unit_root(64 * ((j * c) & 255), co, si); cm[i] = (bf16)(pk2(ri ? -si : co, 0.f) & 0xffffu); }
            for (int i = gt; i < 256 * 256; i += NT) { const int row = i >> 8, col = i & 255, rio = row >> 7, k1 = row & 127, ri = col >> 7, t1 = col & 127; float co, si; unit_root(128 * ((k1 * t1) & 127), co, si);
                const float v = (rio == ri) ? co : (rio ? -si : si); fb1[i] = (bf16)(pk2(v, 0.f) & 0xffffu); }
            for (int i = gt; i < 256 * 256; i += NT) { const int k2 = i >> 8, col = i & 255, ri = col >> 7, t2 = col & 127; float co, si; unit_root(128 * ((k2 * t2) & 127), co, si);
                fc2[i] = (bf16)(pk2(k2 < 128 ? (ri ? si : co) : 0.f, 0.f) & 0xffffu); }
            for (int i = gt; i < 256 * 512; i += NT) { const int k = i >> 9, col = i & 511, ri = col >> 8, t = col & 255; float co, si; unit_root(64 * ((k * t) & 255), co, si); f256[i] = (bf16)(pk2(ri ? si : co, 0.f) & 0xffffu); }
            bf16* cmh = (bf16*)(F.ws + WS_DFT + DFT_CMH);
            for (int i = gt; i < 256 * 256; i += NT) { const int row = i >> 8, c = i & 255, ri = row >> 7, j = row & 127; float co, si; unit_root(64 * (((ri && j == 0 ? 128 : j) * c) & 255), co, si); cmh[i] = (bf16)(pk2((ri && j) ? -si : co, 0.f) & 0xffffu); }
        }
    if (F.bid < 192) {
        LAS float* sv = (LAS float*)(F.lds);
        LAS float* part = (LAS float*)(F.lds + 32768);
        for (int i = F.tid; i < 3 * D; i += 512) { const int r = i / D, k = i % D; const float v = r < 2 ? F.c[r * D + k] : F.c_ctx[k]; sv[i] = silu_f(v); }
        __syncthreads();
        const int l = F.bid / 48, n0 = (F.bid % 48) * 256;
        const float* W = F.w_mod + (size_t)l * D * NMODV + n0 + 4 * F.lane;
        f32x4 a0 = {0.f, 0.f, 0.f, 0.f}, a1 = a0, a2 = a0;
        const int kbeg = F.wave * 256;
#pragma unroll 16
        for (int k = kbeg; k < kbeg + 256; ++k) { const f32x4 w = *(const f32x4*)(W + (size_t)k * NMODV); a0 += w * sv[k]; a1 += w * sv[D + k]; a2 += w * sv[2 * D + k]; }
        *(LAS f32x4*)(part + (F.wave * 3 + 0) * 256 + 4 * F.lane) = a0;
        *(LAS f32x4*)(part + (F.wave * 3 + 1) * 256 + 4 * F.lane) = a1;
        *(LAS f32x4*)(part + (F.wave * 3 + 2) * 256 + 4 * F.lane) = a2;
        __syncthreads();
        float* MOD = (float*)(F.ws + WS_MOD);
        for (int i = F.tid; i < 768; i += 512) { const int r = i >> 8, n = i & 255; float s = 0.f;
#pragma unroll
            for (int w = 0; w < 8; ++w) s += part[(w * 3 + r) * 256 + n];
            MOD[((size_t)l * 3 + r) * NMODV + n0 + n] = s + F.b_mod[(size_t)l * NMODV + n0 + n]; }
        __syncthreads();
    }
    LAS float* scr = (LAS float*)(F.lds + RING_OFF + F.wave * 16384);
    const int gw = F.bid * NWAVES + F.wave, NGW = F.G * NWAVES;
    constexpr int I_WIN_E = (D / 64) * (EIN / 32), I_WO = (D / 64) * (D / 32), I_WIN_O = (D / 64) * (OIN / 32), I_W1 = (D / 64) * (FF / 32), I_W2 = (FF / 64) * (D / 32);
    constexpr int NITEMS = 2 * I_WIN_E + 2 * I_WO + 2 * I_WIN_O + 2 * I_WO + 4 * I_W1 + 4 * I_W2;
    struct TItem { const float* W; bf16* WT; int K, N, perm, item; };
#define T_DECODE(t, it_) { int r = (it_); \
        if (r < 2 * I_WIN_E) { const int a = r / I_WIN_E; t.W = F.att_w_in + (size_t)a * D * EIN; t.WT = (bf16*)(F.ws + WS_WIN_E) + (size_t)a * D * EIN; t.K = D; t.N = EIN; t.perm = 0; t.item = r % I_WIN_E; } \
        else if ((r -= 2 * I_WIN_E) < 2 * I_WO) { const int a = r / I_WO; t.W = F.att_w_out + (size_t)a * D * D; t.WT = (bf16*)(F.ws + WS_WOUT_E) + (size_t)a * D * D; t.K = D; t.N = D; t.perm = 1; t.item = r % I_WO; } \
        else if ((r -= 2 * I_WO) < 2 * I_WIN_O) { const int a = r / I_WIN_O; t.W = F.conv_w_in + (size_t)a * D * OIN; t.WT = (bf16*)(F.ws + WS_WIN_O) + (size_t)a * D * OIN; t.K = D; t.N = OIN; t.perm = 0; t.item = r % I_WIN_O; } \
        else if ((r -= 2 * I_WIN_O) < 2 * I_WO) { const int a = r / I_WO; t.W = F.conv_w_out + (size_t)a * D * D; t.WT = (bf16*)(F.ws + WS_WOUT_O) + (size_t)a * D * D; t.K = D; t.N = D; t.perm = 0; t.item = r % I_WO; } \
        else if ((r -= 2 * I_WO) < 4 * I_W1) { const int a = r / I_W1; t.W = F.mlp_w1 + (size_t)a * D * FF; t.WT = (bf16*)(F.ws + WS_W1) + (size_t)a * D * FF; t.K = D; t.N = FF; t.perm = 0; t.item = r % I_W1; } \
        else { r -= 4 * I_W1; const int a = r / I_W2; t.W = F.mlp_w2 + (size_t)a * D * FF; t.WT = (bf16*)(F.ws + WS_W2) + (size_t)a * D * FF; t.K = FF; t.N = D; t.perm = 0; t.item = r % I_W2; } }
#define T_LOAD(t, v) { const int nblk_ = t.N / 32, k0_ = 64 * (t.item / nblk_), n0_ = 32 * (t.item % nblk_); \
        _Pragma("unroll") for (int i = 0; i < 32; ++i) { const int kk = k0_ + 2 * i + (F.lane >> 5); const int ks = t.perm ? four_slot_channel(kk) : kk; v[i] = t.W[(size_t)ks * t.N + n0_ + (F.lane & 31)]; } }
    if (gw < NITEMS) {
        TItem cur, nxt; float v[32], vn[32];
        T_DECODE(cur, gw) T_LOAD(cur, v)
#pragma unroll 1
        for (int it = gw; it < NITEMS; it += NGW) {
            const bool more = it + NGW < NITEMS;
            if (more) { T_DECODE(nxt, it + NGW) T_LOAD(nxt, vn) }
            const int nblk = cur.N / 32, k0 = 64 * (cur.item / nblk), n0 = 32 * (cur.item % nblk);
#pragma unroll
            for (int i = 0; i < 32; ++i) scr[(2 * i + (F.lane >> 5)) * 33 + (F.lane & 31)] = v[i];
            LDS_WAIT(); asm volatile("" ::: "memory");
            const int c = F.lane & 7;
#pragma unroll
            for (int jj = 0; jj < 4; ++jj) { const int n = (F.lane >> 3) + 8 * jj; const LAS float* sp = scr + (8 * c) * 33 + n;
                v4u o; o.x = pk2(sp[0 * 33], sp[1 * 33]); o.y = pk2(sp[2 * 33], sp[3 * 33]); o.z = pk2(sp[4 * 33], sp[5 * 33]); o.w = pk2(sp[6 * 33], sp[7 * 33]);
                *(v4u*)(cur.WT + (size_t)(n0 + n) * cur.K + k0 + 8 * c) = o; }
            LDS_WAIT(); asm volatile("" ::: "memory");
            if (more) { cur = nxt;
#pragma unroll
                for (int i = 0; i < 32; ++i) v[i] = vn[i]; }
        }
    }
#undef T_DECODE
#undef T_LOAD
}

template <int NR, bool CTX, bool HAS_MO, bool HAS_UX, bool XIN16, bool XOUT16>
__device__ __forceinline__ void r_rows(Frame& F, const float* xin0, const float* xin1, float* xout0, float* xout1, const bf16* mo0, const bf16* mo1, bf16* ux0, bf16* ux1,
                                       const float* sl, int nsplit, const LAS float* pr) {
    f32x4 xv0[8], xv1[8], mv0[8], mv1[8];
#pragma unroll
    for (int j = 0; j < 8; ++j) {
        if (XIN16) { const v2u w = __builtin_nontemporal_load((const v2u*)((const bf16*)xin0 + 256 * j)); xv0[j] = (f32x4){bflo(w.x), bfhi(w.x), bflo(w.y), bfhi(w.y)};
            if (NR == 2) { const v2u w1 = __builtin_nontemporal_load((const v2u*)((const bf16*)xin1 + 256 * j)); xv1[j] = (f32x4){bflo(w1.x), bfhi(w1.x), bflo(w1.y), bfhi(w1.y)}; } }
        else { xv0[j] = __builtin_nontemporal_load((const f32x4*)(xin0 + 256 * j)); if (NR == 2) xv1[j] = __builtin_nontemporal_load((const f32x4*)(xin1 + 256 * j)); } }
    if (HAS_MO) {
        if (CTX && nsplit > 0) {
#pragma unroll
            for (int j = 0; j < 8; ++j) mv0[j] = *(const f32x4*)(sl + 256 * j);
#pragma unroll 1
            for (int sp = 1; sp < nsplit; ++sp) { sl += (size_t)M_CTX * D; f32x4 t[8];
#pragma unroll
                for (int j = 0; j < 8; ++j) t[j] = *(const f32x4*)(sl + 256 * j);
#pragma unroll
                for (int j = 0; j < 8; ++j) mv0[j] += t[j]; }
        } else {
#pragma unroll
            for (int j = 0; j < 8; ++j) { const v2u w = __builtin_nontemporal_load((const v2u*)(mo0 + 256 * j)); mv0[j] = (f32x4){bflo(w.x), bfhi(w.x), bflo(w.y), bfhi(w.y)}; } }
        if (NR == 2) {
#pragma unroll
            for (int j = 0; j < 8; ++j) { const v2u w = __builtin_nontemporal_load((const v2u*)(mo1 + 256 * j)); mv1[j] = (f32x4){bflo(w.x), bfhi(w.x), bflo(w.y), bfhi(w.y)}; } }
        float s0 = 0.f, s1 = 0.f;
#pragma unroll
        for (int j = 0; j < 8; ++j) { s0 += (mv0[j].x * mv0[j].x + mv0[j].y * mv0[j].y) + (mv0[j].z * mv0[j].z + mv0[j].w * mv0[j].w);
            if (NR == 2) s1 += (mv1[j].x * mv1[j].x + mv1[j].y * mv1[j].y) + (mv1[j].z * mv1[j].z + mv1[j].w * mv1[j].w); }
        const float rstd0 = 1.0f / sqrtf(wave_sum(s0) * (1.0f / D) + NORM_EPS), rstd1 = NR == 2 ? 1.0f / sqrtf(wave_sum(s1) * (1.0f / D) + NORM_EPS) : 0.f;
#pragma unroll
        for (int j = 0; j < 8; ++j) { const f32x4 a1 = *(const LAS f32x4*)(pr + 256 * j);
            xv0[j] = xv0[j] + a1 * (mv0[j] * rstd0); if (NR == 2) xv1[j] = xv1[j] + a1 * (mv1[j] * rstd1); }
#pragma unroll
        for (int j = 0; j < 8; ++j) {
            if (XOUT16) { v2u w; w.x = pk2(xv0[j].x, xv0[j].y); w.y = pk2(xv0[j].z, xv0[j].w); __builtin_nontemporal_store(w, (v2u*)((bf16*)xout0 + 256 * j));
                if (NR == 2) { v2u w1; w1.x = pk2(xv1[j].x, xv1[j].y); w1.y = pk2(xv1[j].z, xv1[j].w); __builtin_nontemporal_store(w1, (v2u*)((bf16*)xout1 + 256 * j)); } }
            else { __builtin_nontemporal_store(xv0[j], (f32x4*)(xout0 + 256 * j)); if (NR == 2) __builtin_nontemporal_store(xv1[j], (f32x4*)(xout1 + 256 * j)); } }
    }
    if (HAS_UX) {
        float s0 = 0.f, s1 = 0.f;
#pragma unroll
        for (int j = 0; j < 8; ++j) { s0 += (xv0[j].x * xv0[j].x + xv0[j].y * xv0[j].y) + (xv0[j].z * xv0[j].z + xv0[j].w * xv0[j].w);
            if (NR == 2) s1 += (xv1[j].x * xv1[j].x + xv1[j].y * xv1[j].y) + (xv1[j].z * xv1[j].z + xv1[j].w * xv1[j].w); }
        const float rstd0 = 1.0f / sqrtf(wave_sum(s0) * (1.0f / D) + NORM_EPS), rstd1 = NR == 2 ? 1.0f / sqrtf(wave_sum(s1) * (1.0f / D) + NORM_EPS) : 0.f;
#pragma unroll
        for (int j = 0; j < 8; ++j) { const f32x4 a2 = *(const LAS f32x4*)(pr + D + 256 * j), a3 = *(const LAS f32x4*)(pr + 2 * D + 256 * j);
            { const f32x4 u = (xv0[j] * rstd0) * a2 + a3; v2u w; w.x = pk2(u.x, u.y); w.y = pk2(u.z, u.w); *(v2u*)(ux0 + 256 * j) = w; }
            if (NR == 2) { const f32x4 u = (xv1[j] * rstd1) * a2 + a3; v2u w; w.x = pk2(u.x, u.y); w.y = pk2(u.z, u.w); *(v2u*)(ux1 + 256 * j) = w; } }
    }
}

#define BF4(w) ((f32x4){bflo((w).x), bfhi((w).x), bflo((w).y), bfhi((w).y)})
template <bool HAS_MO, bool HAS_UX, bool XIN16, bool XOUT16>
__device__ __forceinline__ void r_pairs(Frame& F, const float* xsrc, float* xdst, const bf16* MO, bf16* UX, const LAS float* par, int gw, int NGW) {
    const int l4 = 4 * F.lane; const size_t pairstep = (size_t)NGW * D;
    f32x4 rxf0[8], rxf1[8]; v2u rxh0[8], rxh1[8], rm0[8], rm1[8];
#define R_LOAD(m_) { const size_t o0_ = (size_t)(m_) * D + l4, o1_ = o0_ + pairstep; \
        _Pragma("unroll") for (int j = 0; j < 8; ++j) { \
            if (XIN16) { rxh0[j] = __builtin_nontemporal_load((const v2u*)((const bf16*)xsrc + o0_ + 256 * j)); rxh1[j] = __builtin_nontemporal_load((const v2u*)((const bf16*)xsrc + o1_ + 256 * j)); } \
            else { rxf0[j] = __builtin_nontemporal_load((const f32x4*)(xsrc + o0_ + 256 * j)); rxf1[j] = __builtin_nontemporal_load((const f32x4*)(xsrc + o1_ + 256 * j)); } } \
        if (HAS_MO) { _Pragma("unroll") for (int j = 0; j < 8; ++j) { rm0[j] = __builtin_nontemporal_load((const v2u*)(MO + o0_ + 256 * j)); rm1[j] = __builtin_nontemporal_load((const v2u*)(MO + o1_ + 256 * j)); } } }
    int m0 = gw;
    if (m0 < M_TOK) R_LOAD(m0);
#pragma unroll 1
    while (m0 < M_TOK) {
        f32x4 xv0[8], xv1[8]; v2u cm0[8], cm1[8];
#pragma unroll
        for (int j = 0; j < 8; ++j) { xv0[j] = XIN16 ? BF4(rxh0[j]) : rxf0[j]; xv1[j] = XIN16 ? BF4(rxh1[j]) : rxf1[j]; if (HAS_MO) { cm0[j] = rm0[j]; cm1[j] = rm1[j]; } }
        const int mn = m0 + 2 * NGW;
        if (mn < M_TOK) R_LOAD(mn);
        const size_t o0 = (size_t)m0 * D + l4, o1 = o0 + pairstep;
        const LAS float* pr = par + (size_t)(m0 / SEQ) * 3 * D + l4;
        if (HAS_MO) {
            float s0 = 0.f, s1 = 0.f;
#pragma unroll
            for (int j = 0; j < 8; ++j) { const f32x4 a = BF4(cm0[j]), b = BF4(cm1[j]);
                s0 += (a.x * a.x + a.y * a.y) + (a.z * a.z + a.w * a.w); s1 += (b.x * b.x + b.y * b.y) + (b.z * b.z + b.w * b.w); }
            const float rstd0 = 1.0f / sqrtf(wave_sum(s0) * (1.0f / D) + NORM_EPS), rstd1 = 1.0f / sqrtf(wave_sum(s1) * (1.0f / D) + NORM_EPS);
#pragma unroll
            for (int j = 0; j < 8; ++j) { const f32x4 a1 = *(const LAS f32x4*)(pr + 256 * j);
                xv0[j] = xv0[j] + a1 * (BF4(cm0[j]) * rstd0); xv1[j] = xv1[j] + a1 * (BF4(cm1[j]) * rstd1); }
#pragma unroll
            for (int j = 0; j < 8; ++j) {
                if (XOUT16) { v2u w; w.x = pk2(xv0[j].x, xv0[j].y); w.y = pk2(xv0[j].z, xv0[j].w); __builtin_nontemporal_store(w, (v2u*)((bf16*)xdst + o0 + 256 * j));
                    v2u w1; w1.x = pk2(xv1[j].x, xv1[j].y); w1.y = pk2(xv1[j].z, xv1[j].w); __builtin_nontemporal_store(w1, (v2u*)((bf16*)xdst + o1 + 256 * j)); }
                else { __builtin_nontemporal_store(xv0[j], (f32x4*)(xdst + o0 + 256 * j)); __builtin_nontemporal_store(xv1[j], (f32x4*)(xdst + o1 + 256 * j)); } }
        }
        if (HAS_UX) {
            float s0 = 0.f, s1 = 0.f;
#pragma unroll
            for (int j = 0; j < 8; ++j) { s0 += (xv0[j].x * xv0[j].x + xv0[j].y * xv0[j].y) + (xv0[j].z * xv0[j].z + xv0[j].w * xv0[j].w);
                s1 += (xv1[j].x * xv1[j].x + xv1[j].y * xv1[j].y) + (xv1[j].z * xv1[j].z + xv1[j].w * xv1[j].w); }
            const float rstd0 = 1.0f / sqrtf(wave_sum(s0) * (1.0f / D) + NORM_EPS), rstd1 = 1.0f / sqrtf(wave_sum(s1) * (1.0f / D) + NORM_EPS);
#pragma unroll
            for (int j = 0; j < 8; ++j) { const f32x4 a2 = *(const LAS f32x4*)(pr + D + 256 * j), a3 = *(const LAS f32x4*)(pr + 2 * D + 256 * j);
                { const f32x4 u = (xv0[j] * rstd0) * a2 + a3; v2u w; w.x = pk2(u.x, u.y); w.y = pk2(u.z, u.w); *(v2u*)(UX + o0 + 256 * j) = w; }
                { const f32x4 u = (xv1[j] * rstd1) * a2 + a3; v2u w; w.x = pk2(u.x, u.y); w.y = pk2(u.z, u.w); *(v2u*)(UX + o1 + 256 * j) = w; } }
        }
        m0 = mn;
    }
#undef R_LOAD
}

template <bool HAS_MO, bool HAS_UX, bool FIRST>
__device__ __forceinline__ void r_phase_t(Frame& F, int nrows, int nsplit,
                                          const float* modg, int gate_ci, const float* gnorm,
                                          const float* modn, int sh_ci, int sc_ci, const float* gmod) {
    const int gw = F.bid * NWAVES + F.wave, NGW = F.G * NWAVES;
    const bf16* MO = (const bf16*)(F.ws + WS_MO); bf16* UX = RESID_BF16 ? (bf16*)F.out : (bf16*)(F.ws + WS_XB); float* XC = (float*)(F.ws + WS_XC);
    LAS float* par = (LAS float*)F.lds;
    {
    static_assert(D % (NWAVES * 64) == 0, "parameter fill assumes whole strides");
    constexpr int PK = D / (NWAVES * 64);
    float pg[3][PK], pn[PK], pm[PK], psc[3][PK], psh[3][PK];
#pragma unroll
    for (int k = 0; k < PK; ++k) { const int c = F.tid + k * NWAVES * 64;
        if (HAS_MO) pn[k] = gnorm[c];
        if (HAS_UX) pm[k] = gmod[c];
#pragma unroll
        for (int r = 0; r < 3; ++r) {
            if (HAS_MO) pg[r][k] = modg[(size_t)r * NMODV + gate_ci * D + c];
            if (HAS_UX) { psc[r][k] = modn[(size_t)r * NMODV + sc_ci * D + c]; psh[r][k] = modn[(size_t)r * NMODV + sh_ci * D + c]; } } }
#pragma unroll
    for (int k = 0; k < PK; ++k) { const int c = F.tid + k * NWAVES * 64;
#pragma unroll
        for (int r = 0; r < 3; ++r) {
            if (HAS_MO) par[(r * 3 + 0) * D + c] = pg[r][k] * pn[k];
            if (HAS_UX) { par[(r * 3 + 1) * D + c] = pm[k] * (1.0f + psc[r][k]); par[(r * 3 + 2) * D + c] = psh[r][k]; } } }
    }
    __syncthreads();
    const int l4 = 4 * F.lane; constexpr bool first = FIRST;
    bf16* XB = (bf16*)(F.ws + WS_XB);
    constexpr bool XIN16 = RESID_BF16 && !FIRST, XOUT16 = RESID_BF16 && HAS_UX; constexpr int SI = XIN16 ? 2 : 1, SO = XOUT16 ? 2 : 1;
    const float* xsrc = FIRST ? F.x : (XIN16 ? (const float*)XB : F.out); float* xdst = XOUT16 ? (float*)XB : F.out;
    for (int c = F.bid + F.G * F.wave; c < nrows - M_TOK; c += NGW) {
        const float* xin = (first ? F.ctx : XC) + (size_t)c * D + l4;
        r_rows<1, true, HAS_MO, HAS_UX, false, false>(F, xin, xin, XC + (size_t)c * D + l4, nullptr, MO + (size_t)(M_TOK + c) * D + l4, nullptr, UX + (size_t)(M_TOK + c) * D + l4, nullptr,
                                        (const float*)(F.ws + WS_CSP) + (size_t)c * D + l4, nsplit, par + (size_t)2 * 3 * D + l4);
    }
    if (SEQ % (2 * NGW) == 0) {
        r_pairs<HAS_MO, HAS_UX, XIN16, XOUT16>(F, xsrc, xdst, MO, UX, par, gw, NGW);
    } else {
        for (int m0 = gw; m0 < M_TOK; m0 += NGW)
            r_rows<1, false, HAS_MO, HAS_UX, XIN16, XOUT16>(F, xsrc + ((size_t)m0 * D + l4) / SI, nullptr, xdst + ((size_t)m0 * D + l4) / SO, nullptr, MO + (size_t)m0 * D + l4, nullptr, UX + (size_t)m0 * D + l4, nullptr, nullptr, 0, par + (size_t)(m0 / SEQ) * 3 * D + l4);
    }
    __syncthreads();
}
__device__ __forceinline__ void r_phase(Frame& F, int nrows, bool first, bool has_mo, bool has_ux, int nsplit,
                                        const float* modg, int gate_ci, const float* gnorm,
                                        const float* modn, int sh_ci, int sc_ci, const float* gmod) {
    if (!has_mo) r_phase_t<false, true, true>(F, nrows, nsplit, modg, gate_ci, gnorm, modn, sh_ci, sc_ci, gmod);
    else if (first) r_phase_t<true, true, true>(F, nrows, nsplit, modg, gate_ci, gnorm, modn, sh_ci, sc_ci, gmod);
    else if (has_ux) r_phase_t<true, true, false>(F, nrows, nsplit, modg, gate_ci, gnorm, modn, sh_ci, sc_ci, gmod);
    else r_phase_t<true, false, false>(F, nrows, nsplit, modg, gate_ci, gnorm, modn, sh_ci, sc_ci, gmod);
}

typedef float f32x16 __attribute__((ext_vector_type(16)));
typedef short v4i16_t __attribute__((ext_vector_type(4)));
typedef short bf16x8_t __attribute__((ext_vector_type(8)));
constexpr int AT_ROWB = 272, AT_TILEB = 64 * AT_ROWB, AT_BUFB = 2 * AT_TILEB;
__device__ __forceinline__ void attn_mfma(Frame& F, const float* sink, bool with_ctx_q) {
    const bf16* P = (const bf16*)(F.ws + WS_P); bf16* MIX = (bf16*)(F.ws + WS_Z);
    const int lane = F.lane, r = lane & 31, hlf = lane >> 5, hh = F.wave & 1, qs = F.wave >> 1;
    const int nunits = 1024 + (with_ctx_q ? 16 : 0);
    constexpr float LOG2E = 1.4426950408889634f, SC2 = ATTN_SCALE * LOG2E;
    const int c0row = F.tid >> 4, c0ch = F.tid & 15;
    const unsigned st_off0 = (unsigned)(c0row * AT_ROWB + c0ch * 16), st_off1 = st_off0 + 32u * AT_ROWB;
    const int tq = (lane & 15) >> 2, tp = lane & 3, tblk = (lane >> 4) & 1;
    const unsigned vrd = (unsigned)((4 * hlf + tq) * AT_ROWB + (2 * tblk + (tp >> 1)) * 16 + 8 * (tp & 1));
    const unsigned krd = (unsigned)(r * AT_ROWB + 16 * hlf);
    for (int u = F.bid; u < nunits; u += F.G) {
        int b, nb, kvh, gp; const bool cq = u >= 1024;
        if (!cq) { gp = u & 1; kvh = (u >> 1) & 1; nb = (u >> 2) & 127; b = u >> 9; } else { const int v = u - 1024; gp = v & 1; kvh = (v >> 1) & 1; nb = (v >> 2) & 1; b = v >> 3; }
        const int h = kvh * 4 + gp * 2 + hh;
        const size_t qrow = cq ? (size_t)M_TOK + b * CTXL + nb * 128 + qs * 32 + r : (size_t)b * SEQ + nb * 128 + qs * 32 + r;
        bf16x8_t qf[8];
#pragma unroll
        for (int ks = 0; ks < 8; ++ks) qf[ks] = *(const bf16x8_t*)(P + qrow * EIN + 1024 + h * 128 + 16 * ks + 8 * hlf);
        int jlo = 0, jhi = 6; if (cq) { jhi = 0; } else { if (nb == 0) jlo = 2; if (nb == 127) jhi = 4; }
        const int nloc = jhi - jlo, nt = nloc + 4;
        const size_t locrow0 = (size_t)b * SEQ + (size_t)(nb - 1) * 128, ctxrow0 = (size_t)M_TOK + (size_t)b * CTXL;
        const size_t kcol = 2048 + kvh * 128, vcol = 2304 + kvh * 128;
#define AT_TROW(t) ((t) < nloc ? locrow0 + 64 * (size_t)(jlo + (t)) : ctxrow0 + 64 * (size_t)((t) - nloc))
        v4u kst0, kst1, vst0, vst1;
        { const size_t tr0 = AT_TROW(0); const bf16* g0 = P + (tr0 + c0row) * EIN + c0ch * 8; const bf16* g1 = g0 + (size_t)32 * EIN;
          kst0 = *(const v4u*)(g0 + kcol); kst1 = *(const v4u*)(g1 + kcol); vst0 = *(const v4u*)(g0 + vcol); vst1 = *(const v4u*)(g1 + vcol);
          *(LAS v4u*)(F.lds + st_off0) = kst0; *(LAS v4u*)(F.lds + st_off1) = kst1; *(LAS v4u*)(F.lds + AT_TILEB + st_off0) = vst0; *(LAS v4u*)(F.lds + AT_TILEB + st_off1) = vst1; }
        if (nt > 1) { const size_t tr1 = AT_TROW(1); const bf16* g0 = P + (tr1 + c0row) * EIN + c0ch * 8; const bf16* g1 = g0 + (size_t)32 * EIN;
            kst0 = *(const v4u*)(g0 + kcol); kst1 = *(const v4u*)(g1 + kcol); vst0 = *(const v4u*)(g0 + vcol); vst1 = *(const v4u*)(g1 + vcol); }
        __syncthreads();
        f32x16 o0, o1, o2, o3;
#pragma unroll
        for (int i = 0; i < 16; ++i) { o0[i] = 0.f; o1[i] = 0.f; o2[i] = 0.f; o3[i] = 0.f; }
        float m = sink[h] * LOG2E, l = 1.0f;
        const int qi = qs * 32 + r;
        for (int t = 0; t < nt; ++t) {
            v4u kn0, kn1, vn0, vn1;
            if (t + 2 < nt) { const size_t tr2 = AT_TROW(t + 2); const bf16* g0 = P + (tr2 + c0row) * EIN + c0ch * 8; const bf16* g1 = g0 + (size_t)32 * EIN;
                kn0 = *(const v4u*)(g0 + kcol); kn1 = *(const v4u*)(g1 + kcol); vn0 = *(const v4u*)(g0 + vcol); vn1 = *(const v4u*)(g1 + vcol); }
            const LAS unsigned char* kbuf = F.lds + (t & 1) * AT_BUFB; const LAS unsigned char* vbuf = kbuf + AT_TILEB;
            const bool dead = !cq && t < nloc && ((jlo + t == 0 && qs >= 2) || (jlo + t == 5 && qs <= 1));
            if (!dead) {
            f32x16 s0, s1;
#pragma unroll
            for (int i = 0; i < 16; ++i) { s0[i] = 0.f; s1[i] = 0.f; }
#pragma unroll
            for (int ks = 0; ks < 8; ++ks) { const bf16x8_t a0 = *(const LAS bf16x8_t*)(kbuf + krd + ks * 32), a1 = *(const LAS bf16x8_t*)(kbuf + krd + 32 * AT_ROWB + ks * 32);
                s0 = __builtin_amdgcn_mfma_f32_32x32x16_bf16(a0, qf[ks], s0, 0, 0, 0); s1 = __builtin_amdgcn_mfma_f32_32x32x16_bf16(a1, qf[ks], s1, 0, 0, 0); }
            int mtype = 0, kk0 = 0;
            if (!cq && t < nloc) { const int j = jlo + t; if (j < 2) { mtype = 1; kk0 = 64 * j; } else if (j >= 4) { mtype = 2; kk0 = 64 * (j - 4); } }
            float rmx = -1e30f;
#pragma unroll
            for (int i = 0; i < 16; ++i) { const int key = (i & 3) + 8 * (i >> 2) + 4 * hlf; float a = s0[i], c = s1[i];
                if (mtype == 1) { if (kk0 + key < qi) a = -1e30f; if (kk0 + 32 + key < qi) c = -1e30f; }
                if (mtype == 2) { if (kk0 + key > qi) a = -1e30f; if (kk0 + 32 + key > qi) c = -1e30f; }
                s0[i] = a; s1[i] = c; rmx = fmaxf(rmx, fmaxf(a, c)); }
            rmx = fmaxf(rmx, shfl_xor_l(rmx, 32, lane));
            const float cand = rmx * SC2;
            if (__builtin_amdgcn_ballot_w64(cand > m + 8.0f) != 0) {
                const float mn = fmaxf(m, cand); const float alpha = __builtin_amdgcn_exp2f(m - mn); m = mn; l *= alpha;
#pragma unroll
                for (int i = 0; i < 16; ++i) { o0[i] *= alpha; o1[i] *= alpha; o2[i] *= alpha; o3[i] *= alpha; } }
            float rs = 0.f;
#pragma unroll
            for (int i = 0; i < 16; ++i) { const float a = __builtin_amdgcn_exp2f(__builtin_fmaf(s0[i], SC2, -m)), c = __builtin_amdgcn_exp2f(__builtin_fmaf(s1[i], SC2, -m)); s0[i] = a; s1[i] = c; rs += a + c; }
            rs += shfl_xor_l(rs, 32, lane);
            l += rs;
            bf16x8_t pf00, pf01, pf10, pf11;
            { v4u w; w.x = pk2(s0[0], s0[1]); w.y = pk2(s0[2], s0[3]); w.z = pk2(s0[4], s0[5]); w.w = pk2(s0[6], s0[7]); pf00 = __builtin_bit_cast(bf16x8_t, w);
              w.x = pk2(s0[8], s0[9]); w.y = pk2(s0[10], s0[11]); w.z = pk2(s0[12], s0[13]); w.w = pk2(s0[14], s0[15]); pf01 = __builtin_bit_cast(bf16x8_t, w);
              w.x = pk2(s1[0], s1[1]); w.y = pk2(s1[2], s1[3]); w.z = pk2(s1[4], s1[5]); w.w = pk2(s1[6], s1[7]); pf10 = __builtin_bit_cast(bf16x8_t, w);
              w.x = pk2(s1[8], s1[9]); w.y = pk2(s1[10], s1[11]); w.z = pk2(s1[12], s1[13]); w.w = pk2(s1[14], s1[15]); pf11 = __builtin_bit_cast(bf16x8_t, w); }
#define AT_VFRAG(dst, db, kbs) do { const v4i16_t lo_ = __builtin_amdgcn_ds_read_tr16_b64_v4i16((LAS v4i16_t*)(vbuf + vrd + (kbs) * 16 * AT_ROWB + (db) * 64)); \
                const v4i16_t hi_ = __builtin_amdgcn_ds_read_tr16_b64_v4i16((LAS v4i16_t*)(vbuf + vrd + ((kbs) * 16 + 8) * AT_ROWB + (db) * 64)); \
                dst = (bf16x8_t){lo_[0], lo_[1], lo_[2], lo_[3], hi_[0], hi_[1], hi_[2], hi_[3]}; } while (0)
#define AT_PV(oacc, db) do { bf16x8_t vf_; AT_VFRAG(vf_, db, 0); oacc = __builtin_amdgcn_mfma_f32_32x32x16_bf16(vf_, pf00, oacc, 0, 0, 0); AT_VFRAG(vf_, db, 1); oacc = __builtin_amdgcn_mfma_f32_32x32x16_bf16(vf_, pf01, oacc, 0, 0, 0); \
                AT_VFRAG(vf_, db, 2); oacc = __builtin_amdgcn_mfma_f32_32x32x16_bf16(vf_, pf10, oacc, 0, 0, 0); AT_VFRAG(vf_, db, 3); oacc = __builtin_amdgcn_mfma_f32_32x32x16_bf16(vf_, pf11, oacc, 0, 0, 0); } while (0)
            AT_PV(o0, 0); AT_PV(o1, 1); AT_PV(o2, 2); AT_PV(o3, 3);
            }
            if (t + 1 < nt) { LAS unsigned char* nb_ = F.lds + ((t + 1) & 1) * AT_BUFB;
                *(LAS v4u*)(nb_ + st_off0) = kst0; *(LAS v4u*)(nb_ + st_off1) = kst1; *(LAS v4u*)(nb_ + AT_TILEB + st_off0) = vst0; *(LAS v4u*)(nb_ + AT_TILEB + st_off1) = vst1; }
            __syncthreads();
            if (t + 2 < nt) { kst0 = kn0; kst1 = kn1; vst0 = vn0; vst1 = vn1; }
        }
        const float inv = 1.0f / l;
        bf16* orow = MIX + qrow * D + 1024 + h * 128 + 4 * hlf;
#pragma unroll
        for (int g4 = 0; g4 < 4; ++g4) { v2u w;
            w.x = pk2(o0[4 * g4] * inv, o0[4 * g4 + 1] * inv); w.y = pk2(o0[4 * g4 + 2] * inv, o0[4 * g4 + 3] * inv); *(v2u*)(orow + 0 + 8 * g4) = w;
            w.x = pk2(o1[4 * g4] * inv, o1[4 * g4 + 1] * inv); w.y = pk2(o1[4 * g4 + 2] * inv, o1[4 * g4 + 3] * inv); *(v2u*)(orow + 32 + 8 * g4) = w;
            w.x = pk2(o2[4 * g4] * inv, o2[4 * g4 + 1] * inv); w.y = pk2(o2[4 * g4 + 2] * inv, o2[4 * g4 + 3] * inv); *(v2u*)(orow + 64 + 8 * g4) = w;
            w.x = pk2(o3[4 * g4] * inv, o3[4 * g4 + 1] * inv); w.y = pk2(o3[4 * g4 + 2] * inv, o3[4 * g4 + 3] * inv); *(v2u*)(orow + 96 + 8 * g4) = w; }
#undef AT_TROW
#undef AT_VFRAG
#undef AT_PV
    }
}

__device__ __forceinline__ void attn_mfma2(Frame& F, const float* sink, bool with_ctx_q) {
    const bf16* P = (const bf16*)(F.ws + WS_P); bf16* MIX = (bf16*)(F.ws + WS_Z);
    const int lane = F.lane, r = lane & 31, hlf = lane >> 5, hh = F.wave & 1, qs = F.wave >> 1;
    const int nunits = 1024 + (with_ctx_q ? 16 : 0);
    constexpr float LOG2E = 1.4426950408889634f, SC2 = ATTN_SCALE * LOG2E;
    const int c0row = F.tid >> 4, c0ch = F.tid & 15;
    const unsigned st_off0 = (unsigned)(c0row * AT_ROWB + c0ch * 16), st_off1 = st_off0 + 32u * AT_ROWB;
    const int tq = (lane & 15) >> 2, tp = lane & 3, tblk = (lane >> 4) & 1;
    const unsigned vrd = (unsigned)((4 * hlf + tq) * AT_ROWB + (2 * tblk + (tp >> 1)) * 16 + 8 * (tp & 1));
    const unsigned krd = (unsigned)(r * AT_ROWB + 16 * hlf);
    for (int u = F.bid; u < nunits; u += F.G) {
        int b, nb, kvh, gp; const bool cq = u >= 1024;
        if (!cq) { gp = u & 1; kvh = (u >> 1) & 1; nb = (u >> 2) & 127; b = u >> 9; } else { const int v = u - 1024; gp = v & 1; kvh = (v >> 1) & 1; nb = (v >> 2) & 1; b = v >> 3; }
        const int h = kvh * 4 + gp * 2 + hh;
        const size_t qrow = cq ? (size_t)M_TOK + b * CTXL + nb * 128 + qs * 32 + r : (size_t)b * SEQ + nb * 128 + qs * 32 + r;
        bf16x8_t qf[8];
#pragma unroll
        for (int ks = 0; ks < 8; ++ks) qf[ks] = *(const bf16x8_t*)(P + qrow * EIN + 1024 + h * 128 + 16 * ks + 8 * hlf);
        int jlo = 0, jhi = 6; if (cq) { jhi = 0; } else { if (nb == 0) jlo = 2; if (nb == 127) jhi = 4; }
        const int nloc = jhi - jlo, nt = nloc + 4;
        const size_t locrow0 = (size_t)b * SEQ + (size_t)(nb - 1) * 128, ctxrow0 = (size_t)M_TOK + (size_t)b * CTXL;
        const size_t kcol = 2048 + kvh * 128, vcol = 2304 + kvh * 128;
        const int qi = qs * 32 + r;
#define AT_TROW(t) ((t) < nloc ? locrow0 + 64 * (size_t)(jlo + (t)) : ctxrow0 + 64 * (size_t)((t) - nloc))
#define AT_GP(t) (P + (AT_TROW(t) + c0row) * EIN + c0ch * 8)
#define AT_SCORE(d0, d1, kb_) do { _Pragma("unroll") for (int i = 0; i < 16; ++i) { d0[i] = 0.f; d1[i] = 0.f; } \
            _Pragma("unroll") for (int ks = 0; ks < 8; ++ks) { const bf16x8_t a0 = *(const LAS bf16x8_t*)((kb_) + krd + ks * 32), a1 = *(const LAS bf16x8_t*)((kb_) + krd + 32 * AT_ROWB + ks * 32); \
                d0 = __builtin_amdgcn_mfma_f32_32x32x16_bf16(a0, qf[ks], d0, 0, 0, 0); d1 = __builtin_amdgcn_mfma_f32_32x32x16_bf16(a1, qf[ks], d1, 0, 0, 0); } } while (0)
#define AT_MASK(d0, d1, tt) do { int mtype = 0, kk0 = 0; \
            if (!cq && (tt) < nloc) { const int j = jlo + (tt); if (j < 2) { mtype = 1; kk0 = 64 * j; } else if (j >= 4) { mtype = 2; kk0 = 64 * (j - 4); } } \
            int qd = qi - kk0 - 4 * hlf; asm volatile("" : "+v"(qd));     \
            if (mtype == 1) { _Pragma("unroll") for (int i = 0; i < 16; ++i) { const int key = (i & 3) + 8 * (i >> 2); if (key < qd) d0[i] = -1e30f; if (32 + key < qd) d1[i] = -1e30f; } } \
            if (mtype == 2) { _Pragma("unroll") for (int i = 0; i < 16; ++i) { const int key = (i & 3) + 8 * (i >> 2); if (key > qd) d0[i] = -1e30f; if (32 + key > qd) d1[i] = -1e30f; } } } while (0)
        v4u ka0, ka1, va0, va1;
        {   const bf16* g0 = AT_GP(0); const bf16* g1 = AT_GP(1);
            const v4u k00 = *(const v4u*)(g0 + kcol), k01 = *(const v4u*)(g0 + (size_t)32 * EIN + kcol), v00 = *(const v4u*)(g0 + vcol), v01 = *(const v4u*)(g0 + (size_t)32 * EIN + vcol);
            const v4u k10 = *(const v4u*)(g1 + kcol), k11 = *(const v4u*)(g1 + (size_t)32 * EIN + kcol);
            *(LAS v4u*)(F.lds + st_off0) = k00; *(LAS v4u*)(F.lds + st_off1) = k01; *(LAS v4u*)(F.lds + AT_TILEB + st_off0) = v00; *(LAS v4u*)(F.lds + AT_TILEB + st_off1) = v01;
            *(LAS v4u*)(F.lds + AT_BUFB + st_off0) = k10; *(LAS v4u*)(F.lds + AT_BUFB + st_off1) = k11; }
        __syncthreads();
        f32x16 o0, o1, o2, o3;
#pragma unroll
        for (int i = 0; i < 16; ++i) { o0[i] = 0.f; o1[i] = 0.f; o2[i] = 0.f; o3[i] = 0.f; }
        float m = sink[h] * LOG2E, l = 1.0f;
        f32x16 s0, s1;
        AT_SCORE(s0, s1, F.lds); AT_MASK(s0, s1, 0);
        __syncthreads();
        for (int t = 0; t < nt; ++t) {
            if (t + 2 < nt) { const bf16* g = AT_GP(t + 2); ka0 = *(const v4u*)(g + kcol); ka1 = *(const v4u*)(g + (size_t)32 * EIN + kcol); }
            if (t + 1 < nt) { const bf16* g = AT_GP(t + 1); va0 = *(const v4u*)(g + vcol); va1 = *(const v4u*)(g + (size_t)32 * EIN + vcol); }
            const LAS unsigned char* kbufn = F.lds + ((t + 1) & 1) * AT_BUFB; const LAS unsigned char* vbuf = F.lds + (t & 1) * AT_BUFB + AT_TILEB;
            float rmx = -1e30f;
#pragma unroll
            for (int i = 0; i < 16; ++i) rmx = fmaxf(rmx, fmaxf(s0[i], s1[i]));
            rmx = fmaxf(rmx, shfl_xor_l(rmx, 32, lane));
            const float cand = rmx * SC2;
            if (__builtin_amdgcn_ballot_w64(cand > m + 8.0f) != 0) {
                const float mn = fmaxf(m, cand); const float alpha = __builtin_amdgcn_exp2f(m - mn); m = mn; l *= alpha;
#pragma unroll
                for (int i = 0; i < 16; ++i) { o0[i] *= alpha; o1[i] *= alpha; o2[i] *= alpha; o3[i] *= alpha; } }
            f32x16 n0, n1;
            AT_SCORE(n0, n1, kbufn);
            float rs = 0.f;
#pragma unroll
            for (int i = 0; i < 16; ++i) { const float a = __builtin_amdgcn_exp2f(__builtin_fmaf(s0[i], SC2, -m)), c = __builtin_amdgcn_exp2f(__builtin_fmaf(s1[i], SC2, -m)); s0[i] = a; s1[i] = c; rs += a + c; }
            bf16x8_t pf00, pf01, pf10, pf11;
            { v4u w; w.x = pk2(s0[0], s0[1]); w.y = pk2(s0[2], s0[3]); w.z = pk2(s0[4], s0[5]); w.w = pk2(s0[6], s0[7]); pf00 = __builtin_bit_cast(bf16x8_t, w);
              w.x = pk2(s0[8], s0[9]); w.y = pk2(s0[10], s0[11]); w.z = pk2(s0[12], s0[13]); w.w = pk2(s0[14], s0[15]); pf01 = __builtin_bit_cast(bf16x8_t, w);
              w.x = pk2(s1[0], s1[1]); w.y = pk2(s1[2], s1[3]); w.z = pk2(s1[4], s1[5]); w.w = pk2(s1[6], s1[7]); pf10 = __builtin_bit_cast(bf16x8_t, w);
              w.x = pk2(s1[8], s1[9]); w.y = pk2(s1[10], s1[11]); w.z = pk2(s1[12], s1[13]); w.w = pk2(s1[14], s1[15]); pf11 = __builtin_bit_cast(bf16x8_t, w); }
#pragma unroll
            for (int ks = 0; ks < 8; ++ks) { __builtin_amdgcn_sched_group_barrier(0x100, 2, 0); __builtin_amdgcn_sched_group_barrier(0x008, 2, 0); __builtin_amdgcn_sched_group_barrier(0x002, 14, 0); }
            rs += shfl_xor_l(rs, 32, lane);
            l += rs;
#define AT_VFRAG(dst, db, kbs) do { const v4i16_t lo_ = __builtin_amdgcn_ds_read_tr16_b64_v4i16((LAS v4i16_t*)(vbuf + vrd + (kbs) * 16 * AT_ROWB + (db) * 64)); \
                const v4i16_t hi_ = __builtin_amdgcn_ds_read_tr16_b64_v4i16((LAS v4i16_t*)(vbuf + vrd + ((kbs) * 16 + 8) * AT_ROWB + (db) * 64)); \
                dst = (bf16x8_t){lo_[0], lo_[1], lo_[2], lo_[3], hi_[0], hi_[1], hi_[2], hi_[3]}; } while (0)
#define AT_PV(oacc, db) do { bf16x8_t vf_; AT_VFRAG(vf_, db, 0); oacc = __builtin_amdgcn_mfma_f32_32x32x16_bf16(vf_, pf00, oacc, 0, 0, 0); AT_VFRAG(vf_, db, 1); oacc = __builtin_amdgcn_mfma_f32_32x32x16_bf16(vf_, pf01, oacc, 0, 0, 0); \
                AT_VFRAG(vf_, db, 2); oacc = __builtin_amdgcn_mfma_f32_32x32x16_bf16(vf_, pf10, oacc, 0, 0, 0); AT_VFRAG(vf_, db, 3); oacc = __builtin_amdgcn_mfma_f32_32x32x16_bf16(vf_, pf11, oacc, 0, 0, 0); } while (0)
            AT_PV(o0, 0); AT_PV(o1, 1); AT_PV(o2, 2); AT_PV(o3, 3);
            if (t + 1 < nt) AT_MASK(n0, n1, t + 1);
            if (t + 2 < nt) { LAS unsigned char* kw = F.lds + (t & 1) * AT_BUFB; *(LAS v4u*)(kw + st_off0) = ka0; *(LAS v4u*)(kw + st_off1) = ka1; }
            if (t + 1 < nt) { LAS unsigned char* vw = F.lds + ((t + 1) & 1) * AT_BUFB + AT_TILEB; *(LAS v4u*)(vw + st_off0) = va0; *(LAS v4u*)(vw + st_off1) = va1; }
            __syncthreads();
#pragma unroll
            for (int i = 0; i < 16; ++i) { s0[i] = n0[i]; s1[i] = n1[i]; }
        }
        const float inv = 1.0f / l;
        bf16* orow = MIX + qrow * D + 1024 + h * 128 + 4 * hlf;
#pragma unroll
        for (int g4 = 0; g4 < 4; ++g4) { v2u w;
            w.x = pk2(o0[4 * g4] * inv, o0[4 * g4 + 1] * inv); w.y = pk2(o0[4 * g4 + 2] * inv, o0[4 * g4 + 3] * inv); *(v2u*)(orow + 0 + 8 * g4) = w;
            w.x = pk2(o1[4 * g4] * inv, o1[4 * g4 + 1] * inv); w.y = pk2(o1[4 * g4 + 2] * inv, o1[4 * g4 + 3] * inv); *(v2u*)(orow + 32 + 8 * g4) = w;
            w.x = pk2(o2[4 * g4] * inv, o2[4 * g4 + 1] * inv); w.y = pk2(o2[4 * g4 + 2] * inv, o2[4 * g4 + 3] * inv); *(v2u*)(orow + 64 + 8 * g4) = w;
            w.x = pk2(o3[4 * g4] * inv, o3[4 * g4 + 1] * inv); w.y = pk2(o3[4 * g4 + 2] * inv, o3[4 * g4 + 3] * inv); *(v2u*)(orow + 96 + 8 * g4) = w; }
#undef AT_TROW
#undef AT_GP
#undef AT_SCORE
#undef AT_MASK
#undef AT_VFRAG
#undef AT_PV
    }
}

__device__ __forceinline__ void conv_run(Frame& F, const bf16* GB, const bf16* ZG, bf16* AC, const LAS float* wl, int start, int len, bool head_zero, bool tail_zero) {
    const int c0 = 8 * F.lane; const v4u zero4 = {0u, 0u, 0u, 0u};
    v4u z0[4], z1[4], z2[4], z3[4], g0[4], g1[4], n1[4], n2[4], h0[4], h1[4];
#define CV_LD(dst, base, row) { const bf16* p_ = (base) + (size_t)(row) * D + c0; _Pragma("unroll") for (int j = 0; j < 4; ++j) dst[j] = __builtin_nontemporal_load((const v4u*)(p_ + 512 * j)); }
#define CV_Z0(dst) { _Pragma("unroll") for (int j = 0; j < 4; ++j) dst[j] = zero4; }
    if (head_zero) CV_Z0(z0) else CV_LD(z0, ZG, start - 1)
    CV_LD(z1, ZG, start) CV_LD(z2, ZG, start + 1)
    if (len > 2 || !tail_zero) CV_LD(z3, ZG, start + 2) else CV_Z0(z3)
    CV_LD(g0, GB, start) CV_LD(g1, GB, start + 1)
#pragma unroll 1
    for (int t = 0; t < len; t += 2) { const int m = start + t;
        if (t + 2 < len) { CV_LD(n1, ZG, m + 3) if (t + 4 < len || !tail_zero) CV_LD(n2, ZG, m + 4) else CV_Z0(n2) CV_LD(h0, GB, m + 2) CV_LD(h1, GB, m + 3) }
#pragma unroll
        for (int j = 0; j < 4; ++j) { const LAS float* wp = wl + c0 + 512 * j;
            const f32x4 w0a = *(const LAS f32x4*)(wp), w0b = *(const LAS f32x4*)(wp + 4), w1a = *(const LAS f32x4*)(wp + D), w1b = *(const LAS f32x4*)(wp + D + 4), w2a = *(const LAS f32x4*)(wp + 2 * D), w2b = *(const LAS f32x4*)(wp + 2 * D + 4);
#define CV_H(v, e) (((e) & 1) ? bfhi((v)[(e) >> 1]) : bflo((v)[(e) >> 1]))
#define CV_E(o, e, k, W0, W1, W2, G, ZA, ZB, ZC) o[e] = CV_H(G, e) * (W0[k] * CV_H(ZA, e) + W1[k] * CV_H(ZB, e) + W2[k] * CV_H(ZC, e))
#define CV_ROW(G, ZA, ZB, ZC, mrow) { float o[8]; \
                CV_E(o, 0, 0, w0a, w1a, w2a, G, ZA, ZB, ZC); CV_E(o, 1, 1, w0a, w1a, w2a, G, ZA, ZB, ZC); CV_E(o, 2, 2, w0a, w1a, w2a, G, ZA, ZB, ZC); CV_E(o, 3, 3, w0a, w1a, w2a, G, ZA, ZB, ZC); \
                CV_E(o, 4, 0, w0b, w1b, w2b, G, ZA, ZB, ZC); CV_E(o, 5, 1, w0b, w1b, w2b, G, ZA, ZB, ZC); CV_E(o, 6, 2, w0b, w1b, w2b, G, ZA, ZB, ZC); CV_E(o, 7, 3, w0b, w1b, w2b, G, ZA, ZB, ZC); \
                v4u w; w.x = pk2(o[0], o[1]); w.y = pk2(o[2], o[3]); w.z = pk2(o[4], o[5]); w.w = pk2(o[6], o[7]); *(v4u*)(AC + (size_t)(mrow) * D + c0 + 512 * j) = w; }
            CV_ROW(g0[j], z0[j], z1[j], z2[j], m) CV_ROW(g1[j], z1[j], z2[j], z3[j], m + 1)
#undef CV_ROW
#undef CV_E
#undef CV_H
        }
#pragma unroll
        for (int j = 0; j < 4; ++j) { z0[j] = z2[j]; z1[j] = z3[j]; z2[j] = n1[j]; z3[j] = n2[j]; g0[j] = h0[j]; g1[j] = h1[j]; }
    }
#undef CV_LD
#undef CV_Z0
}
__device__ __forceinline__ void conv_phase(Frame& F, const float* cw, int nrows) {
    const bf16* GB = (const bf16*)(F.ws + WS_G); const bf16* ZG = (const bf16*)(F.ws + WS_ZG); bf16* AC = (bf16*)(F.ws + WS_AC);
    const int gw = F.bid * NWAVES + F.wave, NGW = F.G * NWAVES;
    LAS float* wl = (LAS float*)F.lds;
    { float wv[3 * D / (NWAVES * 64)];
#pragma unroll
      for (int k = 0; k < 3 * D / (NWAVES * 64); ++k) wv[k] = cw[F.tid + k * NWAVES * 64];
#pragma unroll
      for (int k = 0; k < 3 * D / (NWAVES * 64); ++k) wl[F.tid + k * NWAVES * 64] = wv[k]; }
    __syncthreads();
    constexpr int RUN = 16;
    for (int ch = gw; ch < M_TOK / RUN; ch += NGW) { const int st = ch * RUN; conv_run(F, GB, ZG, AC, wl, st, RUN, st % SEQ == 0, (st + RUN) % SEQ == 0); }
    for (int c = F.bid + F.G * F.wave; c < (nrows - M_TOK) / 2; c += NGW) { const int st = M_TOK + 2 * c; conv_run(F, GB, ZG, AC, wl, st, 2, (st - M_TOK) % CTXL == 0, (st + 2 - M_TOK) % CTXL == 0); }
    __syncthreads();
}

struct Args { const float* in[15]; float* out; unsigned char* ws; int ph_lo, ph_hi; };
constexpr int PH_PER_LAYER = 16, PH_BASE = 2, PH_END = PH_BASE + DEPTH * PH_PER_LAYER;

__global__ void __launch_bounds__(NWAVES * 64, 2) dit_fwd(Args args) {
    extern __shared__ __attribute__((aligned(16))) unsigned char lds[];
    Frame F;
    F.lds = (LAS unsigned char*)lds;
    F.MISC = (volatile LAS unsigned*)(F.lds + MISC_OFF);
    F.tid = threadIdx.x; F.lane = F.tid & 63; F.wave = __builtin_amdgcn_readfirstlane(F.tid >> 6);
    F.G = gridDim.x; F.bid = blockIdx.x;
    const int wave0 = F.wave;
    F.ws = args.ws; F.out = args.out; F.ctl = (gu32*)(args.ws + WS_CTL);
    F.x = args.in[0]; F.c = args.in[1]; F.ctx = args.in[2]; F.c_ctx = args.in[3]; F.w_mod = args.in[4]; F.b_mod = args.in[5]; F.gains = args.in[6];
    F.att_w_in = args.in[7]; F.att_sink = args.in[8]; F.att_w_out = args.in[9]; F.conv_w_in = args.in[10]; F.conv_w = args.in[11]; F.conv_w_out = args.in[12];
    F.mlp_w1 = args.in[13]; F.mlp_w2 = args.in[14];
    for (int u = F.tid; u < (LDS_BYTES - LDSCTL_OFF) / 4; u += NWAVES * 64) ((LAS unsigned*)(F.lds + LDSCTL_OFF))[u] = 0u;
    __syncthreads();
    const int lo = args.ph_lo, hi = args.ph_hi;
    const bool multi = (hi - lo) > 1;
    XcdBarrier bar; bar.bar = (unsigned*)(F.ctl + CW_BAR); bar.x = 0; bar.st = nullptr;
    if (multi) bar = xcd_barrier_post((unsigned*)(F.ctl + CW_BAR), F.MISC + 8);
#define RELAUNDER() do { int ln_; asm volatile("v_mbcnt_lo_u32_b32 %0, -1, 0\n\tv_mbcnt_hi_u32_b32 %0, -1, %0" : "=v"(ln_)); int wv_ = wave0; asm volatile("" : "+s"(wv_)); F.lane = ln_; F.wave = wv_; F.tid = wv_ * 64 + ln_; } while (0)
#define IN(k) (RELAUNDER_IN(k))
#define RELAUNDER_IN(k) (lo <= (k) && (k) < hi)
#define SEAM(k) do { if (IN(k) && IN((k) + 1)) xcd_barrier(bar); } while (0)
    const float* MOD = (const float*)(F.ws + WS_MOD);
    bf16* UX = RESID_BF16 ? (bf16*)F.out : (bf16*)(F.ws + WS_XB); bf16* MO = (bf16*)(F.ws + WS_MO);

    { if (IN(0)) { p0_prologue(F); } SEAM(0); }
    if (IN(1)) { r_phase(F, MT, true, false, true, 0, MOD, 0, F.gains, MOD, 0, 1, F.gains); } SEAM(1);

    for (int l = 0; l < DEPTH; ++l) {
        const int pb = PH_BASE + l * PH_PER_LAYER;
        RELAUNDER();
        const float* g = F.gains + (size_t)l * 4 * D;
        const float* modl = MOD + (size_t)l * 3 * NMODV;
        const int a = l >> 1;
        const int Mrows = l < 2 ? MT : M_TOK;
        if ((l & 1) == 0) {
            { RELAUNDER(); if (IN(pb + 0)) {
                { RELAUNDER();
                    pg8::Gemm gm = pg8::std_gemm(D); gm.hstepB = (size_t)32 * D * 2;
                    const bf16* Wt = (const bf16*)(F.ws + WS_WIN_E) + (size_t)a * D * EIN;
                    pg8::StdSched S = pg8::std_sched(UX, Wt, M_TOK, EIN, D, F.G, F.bid); S.ext_nM = M_CTX / 256;
                    pg8::EpiInEven E{(bf16*)(F.ws + WS_P), EIN, (const float*)(F.ws + WS_ROPE), M_TOK, SEQ};
                    pg8::gemm_phase<pg8::EpiInEven, pg8::StdSched, PG8_ALIGN, PG8_SP2>(F.lds + RING_OFF, gm, S, E, F.tid); } } }
            SEAM(pb + 0);
            {
            RELAUNDER(); if (IN(pb + 2)) {
                { pg8::Gemm gm; gm.K = 256; gm.pitchA = 512u; gm.hstepA = (size_t)128 * 512; gm.pitchB = 128u * EIN * 2u; gm.hstepB = (size_t)EIN * 2;
                  pg8::FaHSched S; S.init(4 * 128, F.G, F.bid); S.CM = (const char*)(F.ws + WS_DFT + DFT_CMH); S.Pb = (const char*)(F.ws + WS_P); S.pitchP = (size_t)EIN * 2; S.seq = SEQ;
                  pg8::FaHEpi E{(bf16*)(F.ws + WS_Z)};
                  pg8::gemm_phase<pg8::FaHEpi, pg8::FaHSched, PG8_ALIGN, PG8_SP2>(F.lds + RING_OFF, gm, S, E, F.tid); }
                RELAUNDER(); if (l == 0) { pg8::Gemm gm; gm.K = 256; gm.pitchA = 512u; gm.hstepA = (size_t)128 * 512; gm.pitchB = EIN * 2u; gm.hstepB = (size_t)128 * EIN * 2;
                  pg8::FaCtxSched S; S.init(8 * 2, F.G, F.bid); S.CM = (const char*)(F.ws + WS_DFT + DFT_CM); S.Pb = (const char*)(F.ws + WS_P) + (size_t)M_TOK * EIN * 2; S.pitchP = (size_t)EIN * 2;
                  pg8::FaCtxEpi E{(bf16*)(F.ws + WS_ZCTX)};
                  pg8::gemm_phase<pg8::FaCtxEpi, pg8::FaCtxSched, PG8_ALIGN, PG8_SP2>(F.lds + RING_OFF, gm, S, E, F.tid); }
            }
            SEAM(pb + 2);
            RELAUNDER(); if (IN(pb + 3)) {
                pg8::Gemm gm = pg8::std_gemm(256);
                pg8::FbSched S; S.init(516, F.G, F.bid); S.A = (const char*)(F.ws + WS_DFT + DFT_FB1); S.B = (const char*)(F.ws + WS_Z);
                pg8::FbEpi E{(bf16*)(F.ws + WS_A1), (const pg8::f32x2v*)(F.ws + WS_W16K)};
                pg8::gemm_phase<pg8::FbEpi, pg8::FbSched, PG8_ALIGN, PG8_SP2>(F.lds + RING_OFF, gm, S, E, F.tid);
            }
            SEAM(pb + 3);
            RELAUNDER(); if (IN(pb + 4)) {
                { pg8::Gemm gm; gm.K = 256; gm.pitchA = 512u; gm.hstepA = (size_t)128 * 512; gm.pitchB = 128u * 512u; gm.hstepB = (size_t)128 * 128 * 512;
                  pg8::FcSched S; S.init(640, F.G, F.bid); S.A = (const char*)(F.ws + WS_DFT + DFT_FC2); S.B = (const char*)(F.ws + WS_A1);
                  pg8::FcHEpi E{(bf16*)(F.ws + WS_Z), SEQ, D};
                  pg8::gemm_phase<pg8::FcHEpi, pg8::FcSched, PG8_ALIGN, PG8_SP2>(F.lds + RING_OFF, gm, S, E, F.tid); }
                RELAUNDER(); if (l == 0) { pg8::Gemm gm = pg8::std_gemm(512);
                  pg8::FbSched S; S.init(8, F.G, F.bid); S.A = (const char*)(F.ws + WS_DFT + DFT_F256); S.B = (const char*)(F.ws + WS_ZCTX);
                  pg8::CtxSched S2; S2.init(8, F.G, F.bid); S2.A = S.A; S2.B = S.B;
                  pg8::CtxDftEpi E{(bf16*)(F.ws + WS_Z), M_TOK, D};
                  pg8::gemm_phase<pg8::CtxDftEpi, pg8::CtxSched, PG8_ALIGN, PG8_SP2>(F.lds + RING_OFF, gm, S2, E, F.tid); }
                RELAUNDER(); attn_mfma2(F, F.att_sink + a * 8, l == 0);
            }
            SEAM(pb + 4);
            }
        } else {
            { RELAUNDER(); if (IN(pb + 0)) {
                { RELAUNDER();
                    const bf16* Wt = (const bf16*)(F.ws + WS_WIN_O) + (size_t)a * D * OIN; const bf16* Ain = UX; const int Mp = M_TOK; const size_t ro = 0; const int ext = l < 2 ? M_CTX / 256 : 0;
                    { pg8::Gemm gm = pg8::std_gemm(D); pg8::StdSched S = pg8::std_sched(Ain, Wt, Mp, D, D, F.G, F.bid); S.ext_nM = ext;
                      pg8::EpiBf16<0> E{(bf16*)(F.ws + WS_G) + ro, D};
                      pg8::gemm_phase<pg8::EpiBf16<0>, pg8::StdSched, PG8_ALIGN, PG8_SP2>(F.lds + RING_OFF, gm, S, E, F.tid); }
                    RELAUNDER();
                    { pg8::Gemm gm = pg8::std_gemm(D); gm.hstepB = (size_t)2048 * D * 2;
                      pg8::StdSched S = pg8::std_sched(Ain, Wt + (size_t)2048 * D, Mp, 16 * 256, D, F.G, F.bid); S.tsB = (size_t)128 * D * 2; S.ext_nM = ext;
                      pg8::EpiGate E{(bf16*)(F.ws + WS_ZG) + ro, D};
                      pg8::gemm_phase<pg8::EpiGate, pg8::StdSched, PG8_ALIGN, PG8_SP2>(F.lds + RING_OFF, gm, S, E, F.tid); } } } }
            SEAM(pb + 0);
            { RELAUNDER(); if (IN(pb + 1)) { conv_phase(F, F.conv_w + (size_t)a * 3 * D, Mrows); } } SEAM(pb + 1);
        }
        { RELAUNDER(); if (IN(pb + 5)) { const bf16* Ain = (l & 1) ? (const bf16*)(F.ws + WS_AC) : (const bf16*)(F.ws + WS_Z);
            const bf16* Wt = ((l & 1) ? (const bf16*)(F.ws + WS_WOUT_O) : (const bf16*)(F.ws + WS_WOUT_E)) + (size_t)a * D * D;
            { pg8::Gemm gm = pg8::std_gemm(D); pg8::StdSched S = pg8::std_sched(Ain, Wt, M_TOK, D, D, F.G, F.bid);
              pg8::EpiBf16<0> E{MO, D};
              pg8::gemm_phase<pg8::EpiBf16<0>, pg8::StdSched, PG8_ALIGN, PG8_SP2>(F.lds + RING_OFF, gm, S, E, F.tid); }
            RELAUNDER(); if (l < 2) { pg8::Gemm gm = pg8::std_gemm(D); gm.K = 256;
              pg8::SplitKSched S; S.init(8 * 2 * 8, F.G, F.bid); S.A = (const char*)(Ain + (size_t)M_TOK * D); S.B = (const char*)Wt; S.rowpitch = (size_t)D * 2; S.nN = 8; S.Kc = 256;
              pg8::EpiSlab E{(float*)(F.ws + WS_CSP), D};
              pg8::gemm_phase<pg8::EpiSlab, pg8::SplitKSched, PG8_ALIGN, PG8_SP2>(F.lds + RING_OFF, gm, S, E, F.tid); } } }
        SEAM(pb + 5);
        RELAUNDER(); if (IN(pb + 6)) { r_phase(F, Mrows, l == 0, true, true, l < 2 ? 8 : 0, modl, 2, g + D, modl, 3, 4, g + 2 * D); } SEAM(pb + 6);
        RELAUNDER(); if (IN(pb + 7)) {
            { RELAUNDER();
                pg8::Gemm gm = pg8::std_gemm(D); pg8::StdSched S = pg8::std_sched(UX, (const bf16*)(F.ws + WS_W1) + (size_t)l * D * FF, M_TOK, FF, D, F.G, F.bid); S.ext_nM = l < 2 ? M_CTX / 256 : 0;
                pg8::EpiBf16<1> E{(bf16*)(F.ws + WS_H), FF};
                pg8::gemm_phase<pg8::EpiBf16<1>, pg8::StdSched, PG8_ALIGN, PG8_SP2>(F.lds + RING_OFF, gm, S, E, F.tid); } }
        SEAM(pb + 7);
        RELAUNDER(); if (IN(pb + 8)) { const bf16* Wt = (const bf16*)(F.ws + WS_W2) + (size_t)l * D * FF;
            { pg8::Gemm gm = pg8::std_gemm(FF); pg8::StdSched S = pg8::std_sched((const bf16*)(F.ws + WS_H), Wt, M_TOK, D, FF, F.G, F.bid); S.wgm = 4; S.rev = 1;
              pg8::EpiBf16<0> E{MO, D};
              pg8::gemm_phase<pg8::EpiBf16<0>, pg8::StdSched, PG8_ALIGN, PG8_SP2>(F.lds + RING_OFF, gm, S, E, F.tid); }
            RELAUNDER(); if (l < 2) { pg8::Gemm gm = pg8::std_gemm(FF); gm.K = 512;
              pg8::SplitKSched S; S.init(16 * 2 * 8, F.G, F.bid); S.A = (const char*)((const bf16*)(F.ws + WS_H) + (size_t)M_TOK * FF); S.B = (const char*)Wt; S.rowpitch = (size_t)FF * 2; S.nN = 8; S.Kc = 512;
              pg8::EpiSlab E{(float*)(F.ws + WS_CSP), D};
              pg8::gemm_phase<pg8::EpiSlab, pg8::SplitKSched, PG8_ALIGN, PG8_SP2>(F.lds + RING_OFF, gm, S, E, F.tid); } }
        SEAM(pb + 8);
        RELAUNDER(); if (IN(pb + 9)) { const int nr = l < 2 ? MT : M_TOK; const bool ux = l < DEPTH - 1;
            r_phase(F, nr, false, true, ux, l < 2 ? 16 : 0, modl, 5, g + 3 * D, modl + 3 * NMODV, 0, 1, g + 4 * D); }
        if (l < DEPTH - 1) { if (IN(pb + 9) && IN(pb + PH_PER_LAYER)) xcd_barrier(bar); }
    }
#undef IN
#undef SEAM
}

extern "C" void kernel_launch(void* const* d_in, const int* in_sizes, int n_in, void* d_out, int out_size, void* d_ws, size_t ws_size, hipStream_t stream) {
    static int grid = 0;
    if (grid == 0) {
        if (n_in != 15 || out_size != M_TOK * D || ws_size < WS_END) { fprintf(stderr, "kernel_launch: unexpected shapes (n_in %d out %d ws %zu)\n", n_in, out_size, ws_size); grid = -1; return; }
        int dev = 0, cus = 0;
        if (hipGetDevice(&dev) != hipSuccess || hipDeviceGetAttribute(&cus, hipDeviceAttributeMultiprocessorCount, dev) != hipSuccess) { grid = -1; return; }
        if (hipFuncSetAttribute((const void*)dit_fwd, hipFuncAttributeMaxDynamicSharedMemorySize, LDS_BYTES) != hipSuccess) { fprintf(stderr, "kernel_launch: hipFuncSetAttribute failed\n"); grid = -1; return; }
        int per_cu = 0;
        if (hipOccupancyMaxActiveBlocksPerMultiprocessor(&per_cu, (const void*)dit_fwd, NWAVES * 64, LDS_BYTES) != hipSuccess || per_cu < 1) fprintf(stderr, "kernel_launch: occupancy query reports %d\n", per_cu);
        (void)hipGetLastError();
        grid = cus;
    }
    if (grid < 0) return;
    if (hipMemsetAsync((char*)d_ws + WS_CTL, 0, CTL_ZERO_BYTES, stream) != hipSuccess) return;
    Args a{};
    for (int i = 0; i < 15; ++i) a.in[i] = (const float*)d_in[i];
    a.out = (float*)d_out; a.ws = (unsigned char*)d_ws;
    a.ph_lo = 0; a.ph_hi = PH_END;
    hipLaunchKernelGGL(dit_fwd, dim3(grid), dim3(NWAVES * 64), LDS_BYTES, stream, a);
}
```

```cpp
#include <hip/hip_runtime.h>
#ifndef RESID_BF16
#define RESID_BF16 1
#endif
#include <cstdio>
#include <cstdint>


namespace pg8 {
#define PG8_LAS __attribute__((address_space(3)))
typedef unsigned short bf16_t;
typedef short bf16x8 __attribute__((ext_vector_type(8)));
typedef float f32x4 __attribute__((ext_vector_type(4)));
typedef unsigned u32x4 __attribute__((ext_vector_type(4)));
constexpr int BM = 256, BK = 64, HALF = 128, HTB = HALF * BK * 2  , STAGE_BYTES = 8 * HTB, NXCD = 8, WGM = 8;

__host__ __device__ __forceinline__ int lds_byte(int r, int c) { const int st = (r >> 4) * 2 + (c >> 5), rr = r & 15, cc = c & 31, ob = rr * 64 + cc * 2; return st * 1024 + (ob ^ (((ob >> 9) & 1) << 5)); }
__host__ __device__ __forceinline__ void stage_rc(int b, int& R, int& C) { const int st = b / 1024, sb = b % 1024, swz = sb ^ (((sb >> 9) & 1) << 5); R = (st >> 1) * 16 + swz / 64; C = (st & 1) * 32 + (swz % 64) / 2; }
__host__ __device__ __forceinline__ int perm32(int rho) { const int n = rho >> 4, i = rho & 15; return 8 * (i >> 2) + 4 * n + (i & 3); }

struct Unit { int pm, pn; };
struct Gemm { int K; unsigned pitchA, pitchB; size_t hstepA, hstepB; };

struct StaticOrder {
    int nM, nN, nwg, G, c, wgm, rev, ext_nM;
    __host__ __device__ void init(int M, int N, int G_, int c_) { nM = M / BM; nN = N / BM; nwg = nM * nN; G = G_; c = c_; wgm = WGM; rev = 0; ext_nM = 0; }
    __host__ __device__ bool next(int i, Unit& u) const {
        const long L = (long)i * G + c;
        if (L >= nwg) {
            const long L2 = L - nwg; const int nwg2 = ext_nM * nN; if (L2 >= nwg2) return false;
            int w = (int)L2; { const int q = nwg2 / NXCD, r = nwg2 % NXCD, xcd = w % NXCD, off = w / NXCD; w = (xcd < r ? xcd * (q + 1) : r * (q + 1) + (xcd - r) * q) + off; }
            u.pm = nM + w % ext_nM; u.pn = w / ext_nM; return true; }
        int wgid = (int)L; if (rev && nwg % G == 0) { const int rounds = nwg / G; wgid = (rounds - 1 - i) * G + c; }
        { const int q = nwg / NXCD, r = nwg % NXCD, xcd = wgid % NXCD, off = wgid / NXCD; wgid = (xcd < r ? xcd * (q + 1) : r * (q + 1) + (xcd - r) * q) + off; }
        const int nig = wgm * nN, gid = wgid / nig, fm = gid * wgm, gsz = (nM - fm) < wgm ? (nM - fm) : wgm;
        u.pm = fm + ((wgid % nig) % gsz); u.pn = (wgid % nig) / gsz; return true;
    }
    __device__ __forceinline__ void a_ready(const Unit&) const {}
    __device__ __forceinline__ void done(const Unit&) const {}
};


struct StdSched : StaticOrder {
    const char* A; const char* B; size_t tsA, tsB;
    __device__ __forceinline__ const char* a_ptr(const Unit& u) const { return A + (size_t)u.pm * tsA; }
    __device__ __forceinline__ const char* b_ptr(const Unit& u) const { return B + (size_t)u.pn * tsB; }
    __device__ __forceinline__ const char* a_base() const { return A; } __device__ __forceinline__ const char* b_base() const { return B; }
};
__device__ __forceinline__ Gemm std_gemm(int K) { Gemm g; g.K = K; g.pitchA = g.pitchB = (unsigned)K * 2u; g.hstepA = g.hstepB = (size_t)HALF * K * 2; return g; }
__device__ __forceinline__ StdSched std_sched(const bf16_t* A, const bf16_t* Bt, int M, int N, int K, int G, int c) { StdSched S; S.init(M, N, G, c); S.A = (const char*)A; S.B = (const char*)Bt; S.tsA = S.tsB = (size_t)BM * K * 2; return S; }
__device__ __forceinline__ unsigned cvt_pk_bf16(float lo, float hi) { unsigned r; asm volatile("v_cvt_pk_bf16_f32 %0, %1, %2" : "=v"(r) : "v"(lo), "v"(hi)); return r; }

template <int ACT  > struct EpiBf16 {
    static constexpr bool PERM = true, AFTER_DRAIN = false; static constexpr int MIN_STORES = 16;
    static __device__ __forceinline__ int brow(int R) { return (R & ~31) + perm32(R & 31); }
    bf16_t* O; int ldc;
    __device__ __forceinline__ void operator()(const f32x4 (&acc)[2][2][4][2], const Unit& u, int wr, int wc, int fr, int fq) const {
        const int row0 = u.pm * BM + wr * 64 + fr; const int col0 = u.pn * BM + wc * 32 + 8 * fq;
#pragma unroll
        for (int ai = 0; ai < 2; ++ai)
#pragma unroll
            for (int m = 0; m < 4; ++m) { bf16_t* rowp = O + (size_t)(row0 + ai * HALF + m * 16) * ldc + col0;
#pragma unroll
                for (int bj = 0; bj < 2; ++bj) { f32x4 v0 = acc[ai][bj][m][0], v1 = acc[ai][bj][m][1];
                    if (ACT == 1) {
#pragma unroll
                        for (int j = 0; j < 4; ++j) { const float a = fmaxf(v0[j], 0.f), b = fmaxf(v1[j], 0.f); v0[j] = a * a; v1[j] = b * b; } }
                    u32x4 w; w.x = cvt_pk_bf16(v0[0], v0[1]); w.y = cvt_pk_bf16(v0[2], v0[3]); w.z = cvt_pk_bf16(v1[0], v1[1]); w.w = cvt_pk_bf16(v1[2], v1[3]);
                    *(u32x4*)(rowp + bj * HALF) = w; } }
    }
};


struct EpiInEven { static constexpr int MIN_STORES = 0; static constexpr bool PERM = true, AFTER_DRAIN = false;
    static __device__ __forceinline__ int brow(int R) { const int wc = R >> 5, n = (R >> 4) & 1, fq = (R >> 2) & 3, i = R & 3; return (wc >> 1) * 128 + (wc & 1) * 64 + 8 * fq + 4 * n + i; }
    bf16_t* P; int ld; const float* rope  ; int rope_rows, seq;
    __device__ __forceinline__ void operator()(const f32x4 (&acc)[2][2][4][2], const Unit& u, int wr, int wc, int fr, int fq) const {
        const int row0 = u.pm * BM + wr * 64 + fr; const int col0 = u.pn * BM + (wc >> 1) * 128 + (wc & 1) * 64 + 8 * fq;
        const bool dorope = (u.pn >= 4 && u.pn <= 8) && (u.pm * BM < rope_rows);
#pragma unroll
        for (int ai = 0; ai < 2; ++ai)
#pragma unroll
            for (int m = 0; m < 4; ++m) { const int row = row0 + ai * HALF + m * 16; bf16_t* rowp = P + (size_t)row * ld + col0;
                f32x4 a0 = acc[ai][0][m][0], a1 = acc[ai][0][m][1], b0 = acc[ai][1][m][0], b1 = acc[ai][1][m][1];
                if (dorope) { const int t = row % seq, pos = (wc & 1) ? (t & 63) : (t >> 6); const f32x4* cs = (const f32x4*)(rope + ((size_t)pos * 32 + 8 * fq) * 2);
                    const f32x4 c0 = cs[0], c1 = cs[1], c2 = cs[2], c3 = cs[3];
                    f32x4 x0, x1, y0, y1;
                    x0[0] = a0[0] * c0[0] - b0[0] * c0[1]; y0[0] = b0[0] * c0[0] + a0[0] * c0[1]; x0[1] = a0[1] * c0[2] - b0[1] * c0[3]; y0[1] = b0[1] * c0[2] + a0[1] * c0[3];
                    x0[2] = a0[2] * c1[0] - b0[2] * c1[1]; y0[2] = b0[2] * c1[0] + a0[2] * c1[1]; x0[3] = a0[3] * c1[2] - b0[3] * c1[3]; y0[3] = b0[3] * c1[2] + a0[3] * c1[3];
                    x1[0] = a1[0] * c2[0] - b1[0] * c2[1]; y1[0] = b1[0] * c2[0] + a1[0] * c2[1]; x1[1] = a1[1] * c2[2] - b1[1] * c2[3]; y1[1] = b1[1] * c2[2] + a1[1] * c2[3];
                    x1[2] = a1[2] * c3[0] - b1[2] * c3[1]; y1[2] = b1[2] * c3[0] + a1[2] * c3[1]; x1[3] = a1[3] * c3[2] - b1[3] * c3[3]; y1[3] = b1[3] * c3[2] + a1[3] * c3[3];
                    a0 = x0; a1 = x1; b0 = y0; b1 = y1; }
                u32x4 w; w.x = cvt_pk_bf16(a0[0], a0[1]); w.y = cvt_pk_bf16(a0[2], a0[3]); w.z = cvt_pk_bf16(a1[0], a1[1]); w.w = cvt_pk_bf16(a1[2], a1[3]); *(u32x4*)rowp = w;
                w.x = cvt_pk_bf16(b0[0], b0[1]); w.y = cvt_pk_bf16(b0[2], b0[3]); w.z = cvt_pk_bf16(b1[0], b1[1]); w.w = cvt_pk_bf16(b1[2], b1[3]); *(u32x4*)(rowp + 32) = w; }
    } };


struct LinOrder { int nwg, G, c; __device__ __forceinline__ void init(int n, int G_, int c_) { nwg = n; G = G_; c = c_; }
    __device__ __forceinline__ bool nextL(int i, int& L) const { const long x = (long)i * G + c; if (x >= nwg) return false; L = (int)x; return true; }
    __device__ __forceinline__ void a_ready(const Unit&) const {} __device__ __forceinline__ void done(const Unit&) const {} };
struct SplitKSched : LinOrder { const char* A; const char* B; size_t rowpitch; int nN, Kc;
    __device__ __forceinline__ bool next(int i, Unit& u) const { int L; if (!nextL(i, L)) return false; u.pn = L % nN; const int q = L / nN; u.pm = q; return true; }
    __device__ __forceinline__ const char* a_ptr(const Unit& u) const { return A + (size_t)(u.pm & 1) * 256 * rowpitch + (size_t)(u.pm >> 1) * Kc * 2; }
    __device__ __forceinline__ const char* b_ptr(const Unit& u) const { return B + (size_t)u.pn * 256 * rowpitch + (size_t)(u.pm >> 1) * Kc * 2; }
    __device__ __forceinline__ const char* a_base() const { return A; } __device__ __forceinline__ const char* b_base() const { return B; } };
struct EpiSlab { static constexpr int MIN_STORES = 0; static constexpr bool PERM = false, AFTER_DRAIN = false; static __device__ __forceinline__ int brow(int R) { return R; }
    float* slab; int ldc;
    __device__ __forceinline__ void operator()(const f32x4 (&acc)[2][2][4][2], const Unit& u, int wr, int wc, int fr, int fq) const {
        const int row0 = (u.pm >> 1) * 512 + (u.pm & 1) * 256 + wr * 64 + fr, col0 = u.pn * BM + wc * 32 + 4 * fq;
#pragma unroll
        for (int ai = 0; ai < 2; ++ai)
#pragma unroll
            for (int m = 0; m < 4; ++m) { float* rowp = slab + (size_t)(row0 + ai * HALF + m * 16) * ldc + col0;
#pragma unroll
                for (int bj = 0; bj < 2; ++bj)
#pragma unroll
                    for (int n = 0; n < 2; ++n) *(f32x4*)(rowp + bj * HALF + n * 16) = acc[ai][bj][m][n]; }
    } };


struct EpiGate { static constexpr int MIN_STORES = 0; static constexpr bool PERM = true, AFTER_DRAIN = false; static __device__ __forceinline__ int brow(int R) { return (R & ~31) + perm32(R & 31); }
    bf16_t* Z; int ld;
    __device__ __forceinline__ void operator()(const f32x4 (&acc)[2][2][4][2], const Unit& u, int wr, int wc, int fr, int fq) const {
        const int row0 = u.pm * BM + wr * 64 + fr; const int col0 = u.pn * HALF + wc * 32 + 8 * fq;
#pragma unroll
        for (int ai = 0; ai < 2; ++ai)
#pragma unroll
            for (int m = 0; m < 4; ++m) { const f32x4 z0 = acc[ai][0][m][0] * acc[ai][1][m][0], z1 = acc[ai][0][m][1] * acc[ai][1][m][1];
                u32x4 w; w.x = cvt_pk_bf16(z0[0], z0[1]); w.y = cvt_pk_bf16(z0[2], z0[3]); w.z = cvt_pk_bf16(z1[0], z1[1]); w.w = cvt_pk_bf16(z1[2], z1[3]);
                *(u32x4*)(Z + (size_t)(row0 + ai * HALF + m * 16) * ld + col0) = w; }
    } };

struct FaCtxSched : LinOrder { const char* CM; const char* Pb; size_t pitchP;
    __device__ __forceinline__ bool next(int i, Unit& u) const { int L; if (!nextL(i, L)) return false; u.pm = L & 7; u.pn = L >> 3; return true; }
    __device__ __forceinline__ const char* a_ptr(const Unit& u) const { return CM + (size_t)(u.pm & 1) * 256 * 512; }
    __device__ __forceinline__ const char* b_ptr(const Unit& u) const { return Pb + (size_t)u.pn * 256 * pitchP + (size_t)(u.pm >> 1) * 512; }
    __device__ __forceinline__ const char* a_base() const { return CM; } __device__ __forceinline__ const char* b_base() const { return Pb; } };
struct FaCtxEpi { static constexpr int MIN_STORES = 0; static constexpr bool PERM = true, AFTER_DRAIN = false; static __device__ __forceinline__ int brow(int R) { return (R & ~31) + perm32(R & 31); } bf16_t* ZcCtx;
    __device__ __forceinline__ void operator()(const f32x4 (&acc)[2][2][4][2], const Unit& u, int wr, int wc, int fr, int fq) const {
        const int g = u.pm >> 1, ri = u.pm & 1, b = u.pn;
#pragma unroll
        for (int ai = 0; ai < 2; ++ai)
#pragma unroll
            for (int m = 0; m < 4; ++m) { const int j = 128 * ai + 64 * wr + 16 * m + fr;
#pragma unroll
                for (int bj = 0; bj < 2; ++bj) { const f32x4 v0 = acc[ai][bj][m][0], v1 = acc[ai][bj][m][1];
                    u32x4 w; w.x = cvt_pk_bf16(v0[0], v0[1]); w.y = cvt_pk_bf16(v0[2], v0[3]); w.z = cvt_pk_bf16(v1[0], v1[1]); w.w = cvt_pk_bf16(v1[2], v1[3]);
                    *(u32x4*)(ZcCtx + (((size_t)((b * 4 + g) * 256 + j) * 2 + ri) * 256 + 128 * bj + 32 * wc + 8 * fq)) = w; } }
    } };
struct FbSched : LinOrder { const char* A; const char* B;
    __device__ __forceinline__ bool next(int i, Unit& u) const { int L; if (!nextL(i, L)) return false; u.pm = 0; u.pn = L; return true; }
    __device__ __forceinline__ const char* a_ptr(const Unit&) const { return A; }
    __device__ __forceinline__ const char* b_ptr(const Unit& u) const { return B + (size_t)u.pn * 256 * 512; }
    __device__ __forceinline__ const char* a_base() const { return A; } __device__ __forceinline__ const char* b_base() const { return B; } };
typedef float f32x2v __attribute__((ext_vector_type(2)));
struct FbEpi { static constexpr int MIN_STORES = 0; static constexpr bool PERM = true, AFTER_DRAIN = false; static __device__ __forceinline__ int brow(int R) { return (R & ~31) + perm32(R & 31); } bf16_t* A1c; const f32x2v* w16k;
    __device__ __forceinline__ void operator()(const f32x4 (&acc)[2][2][4][2], const Unit& u, int wr, int wc, int fr, int fq) const {
        const int t20 = 32 * wc + 8 * fq;
        f32x2v t0s[4], sts[4];
#pragma unroll
        for (int m = 0; m < 4; ++m) { const int k1 = 64 * wr + 16 * m + fr; t0s[m] = w16k[(k1 * t20) & 16383]; sts[m] = w16k[k1]; }
#pragma unroll
        for (int m = 0; m < 4; ++m) { const int k1 = 64 * wr + 16 * m + fr; const f32x2v t0 = t0s[m], st = sts[m];
            bf16_t* dst0 = A1c + (((size_t)u.pn * 2 * 128 + k1) * 2) * 128 + t20; bf16_t* dst1 = dst0 + (size_t)128 * 2 * 128;
            float cx = t0.x, cy = t0.y; u32x4 wr0, wi0, wr1, wi1; float pr0 = 0.f, pi0 = 0.f, pr1 = 0.f, pi1 = 0.f;
#pragma unroll
            for (int e = 0; e < 8; ++e) { const float ar0 = acc[0][0][m][e >> 2][e & 3], ai0 = acc[1][0][m][e >> 2][e & 3], ar1 = acc[0][1][m][e >> 2][e & 3], ai1 = acc[1][1][m][e >> 2][e & 3];
                const float br0 = ar0 * cx + ai0 * cy, bi0 = ai0 * cx - ar0 * cy, br1 = ar1 * cx + ai1 * cy, bi1 = ai1 * cx - ar1 * cy;
                if (e & 1) { wr0[e >> 1] = cvt_pk_bf16(pr0, br0); wi0[e >> 1] = cvt_pk_bf16(pi0, bi0); wr1[e >> 1] = cvt_pk_bf16(pr1, br1); wi1[e >> 1] = cvt_pk_bf16(pi1, bi1); }
                else { pr0 = br0; pi0 = bi0; pr1 = br1; pi1 = bi1; }
                const float nx = cx * st.x - cy * st.y, ny = cx * st.y + cy * st.x; cx = nx; cy = ny; }
            *(u32x4*)dst0 = wr0; *(u32x4*)(dst0 + 128) = wi0; *(u32x4*)dst1 = wr1; *(u32x4*)(dst1 + 128) = wi1;
            asm volatile("" ::: "memory"); }
    } };
struct FcSched : LinOrder { const char* A; const char* B;
    __device__ __forceinline__ bool next(int i, Unit& u) const { int L; if (!nextL(i, L)) return false; u.pm = L & 127; u.pn = L >> 7; return true; }
    __device__ __forceinline__ const char* a_ptr(const Unit&) const { return A; }
    __device__ __forceinline__ const char* b_ptr(const Unit& u) const { return B + ((size_t)u.pn * 256 * 128 + u.pm) * 512; }
    __device__ __forceinline__ const char* a_base() const { return A; } __device__ __forceinline__ const char* b_base() const { return B; } };
struct CtxSched : LinOrder { const char* A; const char* B;
    __device__ __forceinline__ bool next(int i, Unit& u) const { int L; if (!nextL(i, L)) return false; u.pm = 0; u.pn = L; return true; }
    __device__ __forceinline__ const char* a_ptr(const Unit&) const { return A; }
    __device__ __forceinline__ const char* b_ptr(const Unit& u) const { return B + (size_t)u.pn * 256 * 1024; }
    __device__ __forceinline__ const char* a_base() const { return A; } __device__ __forceinline__ const char* b_base() const { return B; } };
struct CtxDftEpi { static constexpr int MIN_STORES = 0; static constexpr bool PERM = true, AFTER_DRAIN = false; static __device__ __forceinline__ int brow(int R) { return (R & ~31) + perm32(R & 31); } bf16_t* MIXp; int row0, ld;
    __device__ __forceinline__ void operator()(const f32x4 (&acc)[2][2][4][2], const Unit& u, int wr, int wc, int fr, int fq) const {
        const int b = u.pn >> 2, g = u.pn & 3;
#pragma unroll
        for (int ai = 0; ai < 2; ++ai)
#pragma unroll
            for (int m = 0; m < 4; ++m) { const int k = 128 * ai + 64 * wr + 16 * m + fr; bf16_t* rowp = MIXp + ((size_t)row0 + b * 256 + k) * ld + g * 256;
#pragma unroll
                for (int bj = 0; bj < 2; ++bj) { const f32x4 v0 = acc[ai][bj][m][0] * (1.0f / 256.0f), v1 = acc[ai][bj][m][1] * (1.0f / 256.0f); const int j0 = 128 * bj + 32 * wc + 8 * fq;
                    u32x4 w; w.x = cvt_pk_bf16(v0[0], v0[1]); w.y = cvt_pk_bf16(v0[2], v0[3]); w.z = cvt_pk_bf16(v1[0], v1[1]); w.w = cvt_pk_bf16(v1[2], v1[3]);
                    if (bj == 0) *(u32x4*)(rowp + j0) = w;
                    else {
#pragma unroll
                        for (int e = 0; e < 8; ++e) { const int c = j0 + e, sl = c == 128 ? 128 : 384 - c; const unsigned ww = e < 2 ? w.x : (e < 4 ? w.y : (e < 6 ? w.z : w.w)); rowp[sl] = (bf16_t)((e & 1) ? (ww >> 16) : (ww & 0xffffu)); } } } }
    } };


struct FaHSched : LinOrder { const char* CM; const char* Pb; size_t pitchP; int seq;
    __device__ __forceinline__ bool next(int i, Unit& u) const { int L; if (!nextL(i, L)) return false; u.pm = L & 3; u.pn = L >> 2; return true; }
    __device__ __forceinline__ const char* a_ptr(const Unit&) const { return CM; }
    __device__ __forceinline__ const char* b_ptr(const Unit& u) const { const int b = u.pn >> 6, t2 = 2 * (u.pn & 63); return Pb + ((size_t)b * seq + t2) * pitchP + (size_t)u.pm * 512; }
    __device__ __forceinline__ const char* a_base() const { return CM; } __device__ __forceinline__ const char* b_base() const { return Pb; } };
struct FaHEpi { static constexpr int MIN_STORES = 0; static constexpr bool PERM = true, AFTER_DRAIN = false; static __device__ __forceinline__ int brow(int R) { return (R & ~31) + perm32(R & 31); } bf16_t* Zc;
    __device__ __forceinline__ void operator()(const f32x4 (&acc)[2][2][4][2], const Unit& u, int wr, int wc, int fr, int fq) const {
        const int g = u.pm, b = u.pn >> 6, t2p = 2 * (u.pn & 63), bg = b * 4 + g;
#pragma unroll
        for (int ai = 0; ai < 2; ++ai)
#pragma unroll
            for (int m = 0; m < 4; ++m) { const int j = 64 * wr + 16 * m + fr;
#pragma unroll
                for (int bj = 0; bj < 2; ++bj) { const f32x4 v0 = acc[ai][bj][m][0], v1 = acc[ai][bj][m][1];
                    u32x4 w; w.x = cvt_pk_bf16(v0[0], v0[1]); w.y = cvt_pk_bf16(v0[2], v0[3]); w.z = cvt_pk_bf16(v1[0], v1[1]); w.w = cvt_pk_bf16(v1[2], v1[3]);
                    const size_t t2 = (size_t)(t2p + bj), t10 = 32 * wc + 8 * fq;
                    if (ai == 1 && j == 0) {
                        const u32x4 z = {0u, 0u, 0u, 0u};
                        *(u32x4*)(Zc + ((((size_t)(1024 + bg) * 128 + t2) * 2 + 0) * 128 + t10)) = w; *(u32x4*)(Zc + ((((size_t)(1024 + bg) * 128 + t2) * 2 + 1) * 128 + t10)) = z;
                        *(u32x4*)(Zc + ((((size_t)(bg * 128) * 128 + t2) * 2 + 1) * 128 + t10)) = z;
                    } else *(u32x4*)(Zc + ((((size_t)(bg * 128 + j) * 128 + t2) * 2 + ai) * 128 + t10)) = w; } }
    } };
struct FcHEpi { static constexpr int MIN_STORES = 0; static constexpr bool PERM = true, AFTER_DRAIN = false; static __device__ __forceinline__ int brow(int R) { return (R & ~31) + perm32(R & 31); } bf16_t* MIXp; int seq, ld;
    __device__ __forceinline__ void operator()(const f32x4 (&acc)[2][2][4][2], const Unit& u, int wr, int wc, int fr, int fq) const {
        const int k1 = u.pm;
#pragma unroll
        for (int m = 0; m < 4; ++m) { const int k2 = 64 * wr + 16 * m + fr, k = k1 + 128 * k2, km = (seq - k) & (seq - 1);
            if (u.pn < 4) {
#pragma unroll
                for (int bj = 0; bj < 2; ++bj) { const int bg = 2 * u.pn + bj, b = bg >> 2, g = bg & 3, j0 = 32 * wc + 8 * fq;
                    const f32x4 v0 = acc[0][bj][m][0] * (1.0f / 2048.0f), v1 = acc[0][bj][m][1] * (1.0f / 2048.0f);
                    u32x4 w; w.x = cvt_pk_bf16(v0[0], v0[1]); w.y = cvt_pk_bf16(v0[2], v0[3]); w.z = cvt_pk_bf16(v1[0], v1[1]); w.w = cvt_pk_bf16(v1[2], v1[3]);
                    *(u32x4*)(MIXp + ((size_t)b * seq + k) * ld + g * 256 + j0) = w;
                    bf16_t* mp = MIXp + ((size_t)b * seq + km) * ld + g * 256 + 128 + j0;
                    if (j0 != 0) *(u32x4*)mp = w;
                    else { mp[1] = (bf16_t)(w.x >> 16); *(unsigned*)(mp + 2) = w.y; *(unsigned long long*)(mp + 4) = ((unsigned long long)w.w << 32) | w.z; } }
            } else if (wc == 0 && fq == 0) {
                const f32x4 v0 = acc[0][0][m][0] * (1.0f / 2048.0f), v1 = acc[0][0][m][1] * (1.0f / 2048.0f);
#pragma unroll
                for (int e = 0; e < 8; ++e) { const float y = e < 4 ? v0[e & 3] : v1[e & 3]; MIXp[((size_t)(e >> 2) * seq + k) * ld + (e & 3) * 256 + 128] = (bf16_t)(cvt_pk_bf16(y, 0.f) & 0xffffu); }
            } }
    } };

template <class Epi, class Sched, bool ALIGN_EPI = false, bool SP2 = false>
__device__ __forceinline__ void gemm_phase(PG8_LAS unsigned char* lds, const Gemm g, const Sched& S, const Epi& E, const int tid) {
    const int wid = __builtin_amdgcn_readfirstlane(tid >> 6), lane = tid & 63, wr = wid >> 2, wc = wid & 3, fr = lane & 15, fq = lane >> 4;
    int Kl = g.K; asm volatile("" : "+s"(Kl));
    const int nt = Kl / BK;
    unsigned voffA[2], voffB[2];
#pragma unroll
    for (int i = 0; i < 2; ++i) { int R, C; stage_rc(tid * 16 + i * 8192, R, C); const int Rb = Epi::brow(R);
        voffA[i] = (unsigned)R * g.pitchA + (unsigned)C * 2u; voffB[i] = (unsigned)Rb * g.pitchB + (unsigned)C * 2u; }
    const unsigned kstep = (unsigned)(BK * 2);
    const unsigned hstepA = (unsigned)g.hstepA, hstepB = (unsigned)g.hstepB;
    const char* const baseA = S.a_base(); const char* const baseB = S.b_base();
    const __amdgpu_buffer_rsrc_t rs_voffA = __builtin_amdgcn_make_buffer_rsrc((void*)baseA, 0, 0x7fffffff, 0x00020000);
    const __amdgpu_buffer_rsrc_t rs_voffB = __builtin_amdgcn_make_buffer_rsrc((void*)baseB, 0, 0x7fffffff, 0x00020000);
    const unsigned ldsw = (unsigned)wid * 1024u;
    const int aoff = lds_byte(wr * 64 + fr, fq * 8), boff = lds_byte(wc * 32 + fr, fq * 8);
#define PG8_SA(b, h) (((b) * 2 + (h)) * HTB)
#define PG8_SB(b, h) ((4 + (b) * 2 + (h)) * HTB)
#define PG8_STAGE(bufoff, goff, voff) do { _Pragma("unroll") for (int _i = 0; _i < 2; ++_i) \
        __builtin_amdgcn_raw_ptr_buffer_load_lds(rs_##voff, (PG8_LAS unsigned*)(lds + (bufoff) + ldsw + _i * 8192), 16, (voff)[_i], (goff), 0, 0); } while (0)
#define PG8_LDA(dst, b, h) do { _Pragma("unroll") for (int m = 0; m < 4; ++m) _Pragma("unroll") for (int k = 0; k < 2; ++k) dst[m][k] = *(const PG8_LAS bf16x8*)(lds + PG8_SA(b, h) + aoff + m * 2048 + k * 1024); } while (0)
#define PG8_LDB(dst, b, h) do { _Pragma("unroll") for (int n = 0; n < 2; ++n) _Pragma("unroll") for (int k = 0; k < 2; ++k) dst[n][k] = *(const PG8_LAS bf16x8*)(lds + PG8_SB(b, h) + boff + n * 2048 + k * 1024); } while (0)
#define PG8_MMA(ai, bj, At, Bt) do { __builtin_amdgcn_s_setprio(1); _Pragma("unroll") for (int m = 0; m < 4; ++m) _Pragma("unroll") for (int n = 0; n < 2; ++n) _Pragma("unroll") for (int k = 0; k < 2; ++k) \
        acc[ai][bj][m][n] = __builtin_amdgcn_mfma_f32_16x16x32_bf16(Bt[n][k], At[m][k], acc[ai][bj][m][n], 0, 0, 0); __builtin_amdgcn_s_setprio(0); } while (0)
#define PG8_WAIT_V(n) asm volatile("s_waitcnt vmcnt(" #n ")" ::: "memory")
#define PG8_WAIT_L(n) asm volatile("s_waitcnt lgkmcnt(" #n ")" ::: "memory")
#define PG8_BAR __builtin_amdgcn_s_barrier()
#define PG8_SCHED __builtin_amdgcn_sched_barrier(0)
    Unit cur, nxt; int ui = 0;
    if (!S.next(0, cur)) return;
    f32x4 acc[2][2][4][2];
#pragma unroll
    for (int a = 0; a < 2; ++a)
#pragma unroll
        for (int b = 0; b < 2; ++b)
#pragma unroll
            for (int m = 0; m < 4; ++m)
#pragma unroll
                for (int n = 0; n < 2; ++n) acc[a][b][m][n] = (f32x4){0.f, 0.f, 0.f, 0.f};
    bf16x8 At[4][2], B0[2][2], B1[2][2];
    unsigned cA = (unsigned)(S.a_ptr(cur) - baseA), cB = (unsigned)(S.b_ptr(cur) - baseB);
    S.a_ready(cur);
    if constexpr (SP2) {
        PG8_STAGE(PG8_SB(0, 0), cB, voffB); PG8_STAGE(PG8_SB(0, 1), cB + hstepB, voffB); PG8_STAGE(PG8_SA(0, 0), cA, voffA); PG8_STAGE(PG8_SA(0, 1), cA + hstepA, voffA);
        if (wr == 1) PG8_BAR;
        PG8_WAIT_V(2); PG8_BAR;
        PG8_STAGE(PG8_SB(1, 0), cB + kstep, voffB); PG8_STAGE(PG8_SA(1, 0), cA + kstep, voffA); PG8_STAGE(PG8_SB(1, 1), cB + hstepB + kstep, voffB);
        PG8_WAIT_V(6); PG8_BAR;
    } else {
        PG8_STAGE(PG8_SB(0, 0), cB, voffB); PG8_STAGE(PG8_SA(0, 0), cA, voffA); PG8_STAGE(PG8_SB(0, 1), cB + hstepB, voffB); PG8_STAGE(PG8_SA(0, 1), cA + hstepA, voffA);
        if (wr == 1) PG8_BAR;
        PG8_WAIT_V(4); PG8_BAR;
        PG8_STAGE(PG8_SB(1, 0), cB + kstep, voffB); PG8_STAGE(PG8_SA(1, 0), cA + kstep, voffA); PG8_STAGE(PG8_SB(1, 1), cB + hstepB + kstep, voffB);
        PG8_WAIT_V(6); PG8_BAR;
    }
    for (;;) {
        const bool has_next = S.next(ui + 1, nxt);
        const unsigned nA = has_next ? (unsigned)(S.a_ptr(nxt) - baseA) : cA, nB = has_next ? (unsigned)(S.b_ptr(nxt) - baseB) : cB;
        for (int t = 0; t < nt; t += 2) {
            const bool last = (t == nt - 2);
            const unsigned a1 = cA + (unsigned)(t + 1) * kstep;
            const unsigned a2 = last ? nA : cA + (unsigned)(t + 2) * kstep, b2 = last ? nB : cB + (unsigned)(t + 2) * kstep;
            const unsigned a3 = a2 + kstep, b3 = b2 + kstep;
            if (last && has_next) S.a_ready(nxt);
            if constexpr (SP2) {
            const bool relax = Epi::MIN_STORES >= 16 && ui > 0 && t == 0;
            PG8_LDB(B0, 0, 0); PG8_LDB(B1, 0, 1); PG8_SCHED; PG8_LDA(At, 0, 0); PG8_STAGE(PG8_SA(1, 1), a1 + hstepA, voffA);
            if (relax) PG8_WAIT_V(24); else PG8_WAIT_V(8);
            PG8_WAIT_L(0); PG8_BAR; PG8_MMA(0, 0, At, B0); PG8_MMA(0, 1, At, B1); PG8_BAR; PG8_SCHED;
            PG8_LDA(At, 0, 1); PG8_STAGE(PG8_SB(0, 0), b2, voffB); PG8_STAGE(PG8_SB(0, 1), b2 + hstepB, voffB); PG8_STAGE(PG8_SA(0, 0), a2, voffA);
            if (relax) PG8_WAIT_V(24); else PG8_WAIT_V(8);
            PG8_WAIT_L(0); PG8_BAR; PG8_MMA(1, 0, At, B0); PG8_MMA(1, 1, At, B1); PG8_BAR; PG8_SCHED;
            PG8_LDB(B0, 1, 0); PG8_LDB(B1, 1, 1); PG8_SCHED; PG8_LDA(At, 1, 0); PG8_STAGE(PG8_SA(0, 1), a2 + hstepA, voffA);
            PG8_WAIT_V(8); PG8_WAIT_L(0); PG8_BAR; PG8_MMA(0, 0, At, B0); PG8_MMA(0, 1, At, B1); PG8_BAR; PG8_SCHED;
            PG8_LDA(At, 1, 1); PG8_STAGE(PG8_SB(1, 0), b3, voffB); PG8_STAGE(PG8_SB(1, 1), b3 + hstepB, voffB); PG8_STAGE(PG8_SA(1, 0), a3, voffA);
            PG8_WAIT_V(8); PG8_WAIT_L(0); PG8_BAR; PG8_MMA(1, 0, At, B0); PG8_MMA(1, 1, At, B1); PG8_BAR; PG8_SCHED;
            } else {
            PG8_LDB(B0, 0, 0); PG8_SCHED; PG8_LDA(At, 0, 0); PG8_STAGE(PG8_SA(1, 1), a1 + hstepA, voffA);
            PG8_WAIT_L(8); PG8_BAR; PG8_WAIT_L(0); PG8_MMA(0, 0, At, B0); PG8_BAR; PG8_SCHED;
            PG8_LDB(B1, 0, 1); PG8_STAGE(PG8_SB(0, 0), b2, voffB);
            PG8_BAR; PG8_WAIT_L(0); PG8_MMA(0, 1, At, B1); PG8_BAR;
            PG8_LDA(At, 0, 1); PG8_STAGE(PG8_SA(0, 0), a2, voffA);
            PG8_BAR; PG8_WAIT_L(0); PG8_MMA(1, 0, At, B0); PG8_BAR; PG8_SCHED;
            PG8_STAGE(PG8_SB(0, 1), b2 + hstepB, voffB);
            PG8_WAIT_V(6); PG8_BAR; PG8_MMA(1, 1, At, B1); PG8_BAR;
            PG8_LDB(B0, 1, 0); PG8_SCHED; PG8_LDA(At, 1, 0); PG8_STAGE(PG8_SA(0, 1), a2 + hstepA, voffA);
            PG8_WAIT_L(8); PG8_BAR; PG8_WAIT_L(0); PG8_MMA(0, 0, At, B0); PG8_BAR; PG8_SCHED;
            PG8_LDB(B1, 1, 1); PG8_STAGE(PG8_SB(1, 0), b3, voffB);
            PG8_BAR; PG8_WAIT_L(0); PG8_MMA(0, 1, At, B1); PG8_BAR;
            PG8_LDA(At, 1, 1); PG8_STAGE(PG8_SA(1, 0), a3, voffA);
            PG8_BAR; PG8_WAIT_L(0); PG8_MMA(1, 0, At, B0); PG8_BAR; PG8_SCHED;
            PG8_STAGE(PG8_SB(1, 1), b3 + hstepB, voffB);
            PG8_WAIT_V(6); PG8_BAR; PG8_MMA(1, 1, At, B1); PG8_BAR;
            }
        }
        if constexpr (ALIGN_EPI) { if (wr == 0) PG8_BAR; }
        if constexpr (!Epi::AFTER_DRAIN) { E(acc, cur, wr, wc, fr, fq); S.done(cur); }
        if (!has_next) break;
#pragma unroll
        for (int a = 0; a < 2; ++a)
#pragma unroll
            for (int b = 0; b < 2; ++b)
#pragma unroll
                for (int m = 0; m < 4; ++m)
#pragma unroll
                    for (int n = 0; n < 2; ++n) acc[a][b][m][n] = (f32x4){0.f, 0.f, 0.f, 0.f};
        cur = nxt; cA = nA; cB = nB; ++ui;
        if constexpr (ALIGN_EPI) { if (wr == 1) PG8_BAR; }
    }
    PG8_WAIT_V(0);
    if constexpr (!ALIGN_EPI) { if (wr == 0) PG8_BAR; }
    PG8_BAR;
#undef PG8_SA
#undef PG8_SB
#undef PG8_STAGE
#undef PG8_LDA
#undef PG8_LDB
#undef PG8_MMA
#undef PG8_WAIT_V
#undef PG8_WAIT_L
#undef PG8_BAR
#undef PG8_SCHED
}
}

#define PG8_SP2 true
#define PG8_ALIGN true

constexpr int NWAVES = 8;
constexpr int D = 2048, SEQ = 16384, NBATCH = 2, M_TOK = NBATCH * SEQ, CTXL = 256, M_CTX = NBATCH * CTXL, MT = M_TOK + M_CTX, DEPTH = 4;
constexpr int FF = 8192, EIN = 2560, OIN = 6144, NMODV = 6 * D;
constexpr float NORM_EPS = 1e-6f;
constexpr float ATTN_SCALE = 0.08838834764831845f;

constexpr size_t MiB = 1u << 20;
constexpr size_t WS_CTL = 0, CTL_ZERO_BYTES = 1 * MiB;
constexpr size_t WS_MOD = 1 * MiB;
constexpr size_t WS_ROPE = 2 * MiB;
constexpr size_t WS_W16K = 2 * MiB + 128 * 1024;
constexpr size_t WS_DFT = 3 * MiB;
constexpr size_t DFT_CM = 0, DFT_FB1 = 512 * 256 * 2, DFT_FC2 = DFT_FB1 + 256 * 256 * 2, DFT_F256 = DFT_FC2 + 256 * 256 * 2, DFT_CMH = DFT_F256 + 256 * 512 * 2;
constexpr size_t WS_XC = 4 * MiB;
constexpr size_t WS_WIN_E = 8 * MiB;
constexpr size_t WS_WOUT_E = 28 * MiB;
constexpr size_t WS_WIN_O = 44 * MiB;
constexpr size_t WS_WOUT_O = 92 * MiB;
constexpr size_t WS_W1 = 108 * MiB;
constexpr size_t WS_W2 = 236 * MiB;
constexpr size_t WS_XB = 364 * MiB;
constexpr size_t WS_MO = 494 * MiB;
constexpr size_t WS_BIG = 624 * MiB;
constexpr size_t WS_H = WS_BIG;
constexpr size_t WS_P = WS_BIG;
constexpr size_t WS_Z = WS_BIG + 164 * MiB;
constexpr size_t WS_A1 = WS_BIG + 296 * MiB;
constexpr size_t WS_ZCTX = WS_BIG + 428 * MiB;
constexpr size_t WS_G = WS_BIG;
constexpr size_t WS_ZG = WS_BIG + 130 * MiB;
constexpr size_t WS_AC = WS_BIG + 390 * MiB;
constexpr size_t WS_CSP = WS_BIG + 520 * MiB;
constexpr size_t WS_END = WS_CSP + 64 * MiB;
constexpr int CW_BAR = 4096;

constexpr int RING_OFF = 0, RING_BYTES = 131072;
constexpr int LDSCTL_OFF = RING_BYTES, MISC_OFF = LDSCTL_OFF + 320;
constexpr int LDS_BYTES = 147456;

#define GAS __attribute__((address_space(1)))
#define LAS __attribute__((address_space(3)))
typedef unsigned short bf16;
typedef unsigned v4u __attribute__((ext_vector_type(4)));
typedef unsigned v2u __attribute__((ext_vector_type(2)));
typedef float f32x4 __attribute__((ext_vector_type(4)));
typedef float f32x2 __attribute__((ext_vector_type(2)));
typedef GAS unsigned gu32;
#define RLX_AGENT __ATOMIC_RELAXED, __HIP_MEMORY_SCOPE_AGENT
#define LDS_WAIT() asm volatile("s_waitcnt lgkmcnt(0)" ::: "memory")
#define VM_WAIT() asm volatile("s_waitcnt vmcnt(0)" ::: "memory")
__device__ __forceinline__ unsigned pk2(float lo, float hi) { return pg8::cvt_pk_bf16(lo, hi); }
__device__ __forceinline__ float bflo(unsigned v) { return __uint_as_float(v << 16); }
__device__ __forceinline__ float bfhi(unsigned v) { return __uint_as_float(v & 0xffff0000u); }

#define XB_TMO      128
#define XB_XCNT(j)  (256  + 64 * (j))
#define XB_XSUB(j)  (1280 + 64 * (j))
#define XB_XGEN(j)  (2304 + 64 * (j))
#define XB_TOP      3328
#define XB_TOPGEN   3392
#define XCD_BAR_WORDS 3456
#define XB_SPIN_CAP (1u << 22)
__device__ __forceinline__ unsigned xb_ld(unsigned* p)              { return __hip_atomic_load(p, __ATOMIC_RELAXED, __HIP_MEMORY_SCOPE_AGENT); }
__device__ __forceinline__ unsigned xb_add(unsigned* p, unsigned v) { return __hip_atomic_fetch_add(p, v, __ATOMIC_RELAXED, __HIP_MEMORY_SCOPE_AGENT); }
__device__ __forceinline__ unsigned xb_xcc_id() { return (unsigned)__builtin_amdgcn_s_getreg((3 << 11) | 20) & 0xFu; }
#define XB_SPIN(cond, bar) do { unsigned _sp = 0; while (cond) { __builtin_amdgcn_s_sleep(1); \
    if ((++_sp & 255u) == 0u) { if (xb_ld(&(bar)[XB_TMO])) break; if (_sp > XB_SPIN_CAP) { atomicAdd(&(bar)[XB_TMO], 1u); break; } } } } while (0)
struct XcdBarrier { unsigned* bar; unsigned x; volatile LAS unsigned* st; };
__device__ __forceinline__ XcdBarrier xcd_barrier_post(unsigned* bar, volatile LAS unsigned* st) {
    XcdBarrier b; b.bar = bar; b.x = xb_xcc_id(); b.st = st;
    if (threadIdx.x == 0) (void)xb_add(&bar[XB_XCNT(b.x)], 1u);
    return b;
}
__device__ __forceinline__ void xcd_barrier_complete(unsigned* bar, unsigned x, unsigned& nloc, unsigned& nx) {
    const unsigned G = gridDim.x * gridDim.y * gridDim.z;
    unsigned sum, cnt, mine, sp = 0u;
    for (;;) {
        sum = 0u; cnt = 0u; mine = 0u;
#pragma unroll
        for (unsigned j = 0; j < 16; ++j) { const unsigned c = xb_ld(&bar[XB_XCNT(j)]); sum += c; cnt += (c > 0u) ? 1u : 0u; mine = (j == x) ? c : mine; }
        if (sum == G) break;
        __builtin_amdgcn_s_sleep(1);
        if ((++sp & 255u) == 0u) { if (xb_ld(&bar[XB_TMO])) break; if (sp > XB_SPIN_CAP) { atomicAdd(&bar[XB_TMO], 1u); break; } }
    }
    nloc = mine > 0u ? mine : 1u; nx = cnt > 0u ? cnt : 1u;
}
__device__ __forceinline__ void xcd_barrier_census_early(const XcdBarrier& b) {
    if (threadIdx.x == 0 && b.st) { unsigned nloc = b.st[0], nx = b.st[1]; if (nloc == 0u) { xcd_barrier_complete(b.bar, b.x, nloc, nx); b.st[0] = nloc; b.st[1] = nx; } }
}
__device__ __forceinline__ void xcd_barrier(const XcdBarrier& b) {
    asm volatile("s_waitcnt vmcnt(0)" ::: "memory");
    __syncthreads();
    if (threadIdx.x == 0) {
        unsigned* bar = b.bar;
        __builtin_amdgcn_s_waitcnt(0);
        unsigned nloc = b.st[0], nx = b.st[1];
        if (nloc == 0u) { xcd_barrier_complete(bar, b.x, nloc, nx); b.st[0] = nloc; b.st[1] = nx; }
        const unsigned old = xb_add(&bar[XB_XSUB(b.x)], 1u);
        const unsigned gen = old / nloc;
        if (old + 1u == (gen + 1u) * nloc) {
            __builtin_amdgcn_fence(__ATOMIC_RELEASE, "agent");
            asm volatile("s_waitcnt vmcnt(0)" ::: "memory");
            const unsigned og = xb_add(&bar[XB_TOP], 1u);
            const unsigned tg = og / nx;
            if (og + 1u == (tg + 1u) * nx) xb_add(&bar[XB_TOPGEN], 1u);
            else XB_SPIN(xb_ld(&bar[XB_TOPGEN]) == tg, bar);
            __builtin_amdgcn_fence(__ATOMIC_ACQUIRE, "agent");
            xb_add(&bar[XB_XGEN(b.x)], 1u);
            asm volatile("s_waitcnt vmcnt(0)" ::: "memory");
        } else {
            XB_SPIN(xb_ld(&bar[XB_XGEN(b.x)]) == gen, bar);
            __builtin_amdgcn_fence(__ATOMIC_ACQUIRE, "agent");
            asm volatile("s_waitcnt vmcnt(0)" ::: "memory");
        }
    }
    __syncthreads();
}

struct Frame {
    LAS unsigned char* lds;
    volatile LAS unsigned* MISC;
    gu32* ctl;
    int tid, lane, wave, G, bid;
    const float *x, *c, *ctx, *c_ctx, *w_mod, *b_mod, *gains, *att_w_in, *att_sink, *att_w_out, *conv_w_in, *conv_w, *conv_w_out, *mlp_w1, *mlp_w2;
    float* out; unsigned char* ws;
};

__device__ __forceinline__ float shfl_xor_l(float v, int mask, int lane) { return __int_as_float(__builtin_amdgcn_ds_bpermute((lane ^ mask) << 2, __float_as_int(v))); }
__device__ __forceinline__ float wave_sum_l(float v, int  ) {
#define WS_DPP(ctrl, rmask, bc) __int_as_float(__builtin_amdgcn_update_dpp(0, __float_as_int(v), (ctrl), (rmask), 0xf, (bc)))
    v += WS_DPP(0x111, 0xf, true); v += WS_DPP(0x112, 0xf, true); v += WS_DPP(0x114, 0xf, true); v += WS_DPP(0x118, 0xf, true);
    v += WS_DPP(0x142, 0xa, false);
    v += WS_DPP(0x143, 0xc, false);
#undef WS_DPP
    return __int_as_float(__builtin_amdgcn_readlane(__float_as_int(v), 63));
}
__device__ __forceinline__ float wave_max_l(float v, int lane) {
#pragma unroll
    for (int o = 1; o < 64; o <<= 1) v = fmaxf(v, shfl_xor_l(v, o, lane));
    return v;
}
#define wave_sum(v) wave_sum_l((v), F.lane)
#define wave_max(v) wave_max_l((v), F.lane)

__device__ __forceinline__ void dsincos_small(double r, double& s, double& c) {
    const double r2 = r * r; double ts = 1.0, tc = 1.0, ss = 1.0, cs = 1.0;
#pragma unroll
    for (int n = 1; n <= 11; ++n) { tc *= -r2 * (1.0 / (double)((2 * n - 1) * (2 * n))); cs += tc; ts *= -r2 * (1.0 / (double)((2 * n) * (2 * n + 1))); ss += ts; }
    s = r * ss; c = cs;
}
__device__ __forceinline__ void unit_root(int p, float& co, float& si) {
    const int quad = p >> 12; int rem = p & 4095; bool sw = false;
    if (rem > 2048) { rem = 4096 - rem; sw = true; }
    double s, c; dsincos_small((double)rem * (6.283185307179586476925 / 16384.0), s, c);
    if (sw) { const double t = s; s = c; c = t; }
    double cc = (quad & 1) ? -s : c, sn = (quad & 1) ? c : s;
    if (quad & 2) { cc = -cc; sn = -sn; }
    co = (float)cc; si = (float)sn;
}

__device__ __forceinline__ int four_slot_channel(int k) { const int s_ = k & 255; return k < 1024 ? (k & ~255) + (s_ <= 128 ? s_ : 384 - s_) : k; }
template <bool KPERM = false>
__device__ __forceinline__ void p0_transpose_item(const float* W, int K, int N, bf16* WT, LAS float* scr, int item, int lane) {
    const int nblk = N / 32, kb = item / nblk, nb = item % nblk, k0 = 64 * kb, n0 = 32 * nb;
#pragma unroll 8
    for (int i = 0; i < 32; ++i) { const int kk = 2 * i + (lane >> 5); const int ks = KPERM ? four_slot_channel(k0 + kk) : k0 + kk; scr[kk * 33 + (lane & 31)] = W[(size_t)ks * N + n0 + (lane & 31)]; }
    LDS_WAIT(); asm volatile("" ::: "memory");
    const int c = lane & 7;
#pragma unroll
    for (int j = 0; j < 4; ++j) { const int n = (lane >> 3) + 8 * j; const LAS float* s = scr + (8 * c) * 33 + n;
        v4u o; o.x = pk2(s[0 * 33], s[1 * 33]); o.y = pk2(s[2 * 33], s[3 * 33]); o.z = pk2(s[4 * 33], s[5 * 33]); o.w = pk2(s[6 * 33], s[7 * 33]);
        *(v4u*)(WT + (size_t)(n0 + n) * K + k0 + 8 * c) = o; }
    LDS_WAIT(); asm volatile("" ::: "memory");
}

__device__ __forceinline__ float silu_f(float v) { return v / (1.0f + expf(-v)); }

__device__ __forceinline__ void p0_prologue(Frame& F, const XcdBarrier& bar) {
    const int gt = F.bid * 512 + F.tid, NT = F.G * 512;
    {
        f32x2* rope = (f32x2*)(F.ws + WS_ROPE); f32x2* w16k = (f32x2*)(F.ws + WS_W16K);
        for (int i = gt; i < 16384; i += NT) { float co, si; unit_root(i, co, si); w16k[i] = (f32x2){co, si}; }
        for (int i = gt; i < 256 * 32; i += NT) {
            const int pos = i >> 5, fi = i & 31;
            const double s3 = sqrt(sqrt(sqrt(0.1)));
            double f = 1.0; for (int k = 0; k < fi; ++k) f *= s3;
            const float invf = (float)f; const float af = (float)pos * invf;
            const double a = (double)af; const double kq = rint(a * 0.63661977236758134308);
            const double r = (a - kq * 1.57079632679489655800) - kq * 6.123233995736766036e-17;
            double s, c; dsincos_small(r, s, c); const int q = ((int)kq) & 3; double cc = (q & 1) ? -s : c, sn = (q & 1) ? c : s;
            if (q & 2) { cc = -cc; sn = -sn; }
            rope[i] = (f32x2){(float)cc, (float)sn};
        }
    }
    {
            bf16* cm = (bf16*)(F.ws + WS_DFT + DFT_CM); bf16* fb1 = (bf16*)(F.ws + WS_DFT + DFT_FB1); bf16* fc2 = (bf16*)(F.ws + WS_DFT + DFT_FC2); bf16* f256 = (bf16*)(F.ws + WS_DFT + DFT_F256);
            for (int i = gt; i < 512 * 256; i += NT) { const int row = i >> 8, c = i & 255, ri = row >> 8, j = row & 255; float co, si; unit_root(64 * ((j * c) & 255), co, si); cm[i] = (bf16)(pk2(ri ? -si : co, 0.f) & 0xffffu); }
            for (int i = gt; i < 256 * 256; i += NT) { const int row = i >> 8, col = i & 255, rio = row >> 7, k1 = row & 127, ri = col >> 7, t1 = col & 127; float co, si; unit_root(128 * ((k1 * t1) & 127), co, si);
                const float v = (rio == ri) ? co : (rio ? -si : si); fb1[i] = (bf16)(pk2(v, 0.f) & 0xffffu); }
            for (int i = gt; i < 256 * 256; i += NT) { const int k2 = i >> 8, col = i & 255, ri = col >> 7, t2 = col & 127; float co, si; unit_root(128 * ((k2 * t2) & 127), co, si);
                fc2[i] = (bf16)(pk2(k2 < 128 ? (ri ? si : co) : 0.f, 0.f) & 0xffffu); }
            for (int i = gt; i < 256 * 512; i += NT) { const int k = i >> 9, col = i & 511, ri = col >> 8, t = col & 255; float co, si; unit_root(64 * ((k * t) & 255), co, si); f256[i] = (bf16)(pk2(ri ? si : co, 0.f) & 0xffffu); }
            bf16* cmh = (bf16*)(F.ws + WS_DFT + DFT_CMH);
            for (int i = gt; i < 256 * 256; i += NT) { const int row = i >> 8, c = i & 255, ri = row >> 7, j = row & 127; float co, si; unit_root(64 * (((ri && j == 0 ? 128 : j) * c) & 255), co, si); cmh[i] = (bf16)(pk2((ri && j) ? -si : co, 0.f) & 0xffffu); }
        }
    if (F.bid < 192) {
        LAS float* sv = (LAS float*)(F.lds);
        LAS float* part = (LAS float*)(F.lds + 32768);
        { float cv[3 * D / 512];
#pragma unroll
          for (int q = 0; q < 3 * D / 512; ++q) { const int i = F.tid + 512 * q, r = i / D, k = i % D; cv[q] = r < 2 ? F.c[r * D + k] : F.c_ctx[k]; }
#pragma unroll
          for (int q = 0; q < 3 * D / 512; ++q) sv[F.tid + 512 * q] = silu_f(cv[q]); }
        __syncthreads();
        const int l = F.bid / 48, n0 = (F.bid % 48) * 256;
        const float* W = F.w_mod + (size_t)l * D * NMODV + n0 + 4 * F.lane;
        f32x4 a0 = {0.f, 0.f, 0.f, 0.f}, a1 = a0, a2 = a0;
        const int kbeg = F.wave * 256;
#pragma unroll 16
        for (int k = kbeg; k < kbeg + 256; ++k) { const f32x4 w = *(const f32x4*)(W + (size_t)k * NMODV); a0 += w * sv[k]; a1 += w * sv[D + k]; a2 += w * sv[2 * D + k]; }
        *(LAS f32x4*)(part + (F.wave * 3 + 0) * 256 + 4 * F.lane) = a0;
        *(LAS f32x4*)(part + (F.wave * 3 + 1) * 256 + 4 * F.lane) = a1;
        *(LAS f32x4*)(part + (F.wave * 3 + 2) * 256 + 4 * F.lane) = a2;
        __syncthreads();
        float* MOD = (float*)(F.ws + WS_MOD);
        for (int i = F.tid; i < 768; i += 512) { const int r = i >> 8, n = i & 255; float s = 0.f;
#pragma unroll
            for (int w = 0; w < 8; ++w) s += part[(w * 3 + r) * 256 + n];
            MOD[((size_t)l * 3 + r) * NMODV + n0 + n] = s + F.b_mod[(size_t)l * NMODV + n0 + n]; }
        __syncthreads();
    }
    xcd_barrier_census_early(bar);
    LAS float* scr = (LAS float*)(F.lds + RING_OFF + F.wave * 16384);
    const int gw = F.bid * NWAVES + F.wave, NGW = F.G * NWAVES;
    constexpr int I_WIN_E = (D / 64) * (EIN / 32), I_WO = (D / 64) * (D / 32), I_WIN_O = (D / 64) * (OIN / 32), I_W1 = (D / 64) * (FF / 32), I_W2 = (FF / 64) * (D / 32);
    constexpr int NITEMS = 2 * I_WIN_E + 2 * I_WO + 2 * I_WIN_O + 2 * I_WO + 4 * I_W1 + 4 * I_W2;
    struct TItem { const float* W; bf16* WT; int K, N, perm, item; };
#define T_DECODE(t, it_) { int r = (it_); \
        if (r < 2 * I_WIN_E) { const int a = r / I_WIN_E; t.W = F.att_w_in + (size_t)a * D * EIN; t.WT = (bf16*)(F.ws + WS_WIN_E) + (size_t)a * D * EIN; t.K = D; t.N = EIN; t.perm = 0; t.item = r % I_WIN_E; } \
        else if ((r -= 2 * I_WIN_E) < 2 * I_WO) { const int a = r / I_WO; t.W = F.att_w_out + (size_t)a * D * D; t.WT = (bf16*)(F.ws + WS_WOUT_E) + (size_t)a * D * D; t.K = D; t.N = D; t.perm = 1; t.item = r % I_WO; } \
        else if ((r -= 2 * I_WO) < 2 * I_WIN_O) { const int a = r / I_WIN_O; t.W = F.conv_w_in + (size_t)a * D * OIN; t.WT = (bf16*)(F.ws + WS_WIN_O) + (size_t)a * D * OIN; t.K = D; t.N = OIN; t.perm = 0; t.item = r % I_WIN_O; } \
        else if ((r -= 2 * I_WIN_O) < 2 * I_WO) { const int a = r / I_WO; t.W = F.conv_w_out + (size_t)a * D * D; t.WT = (bf16*)(F.ws + WS_WOUT_O) + (size_t)a * D * D; t.K = D; t.N = D; t.perm = 0; t.item = r % I_WO; } \
        else if ((r -= 2 * I_WO) < 4 * I_W1) { const int a = r / I_W1; t.W = F.mlp_w1 + (size_t)a * D * FF; t.WT = (bf16*)(F.ws + WS_W1) + (size_t)a * D * FF; t.K = D; t.N = FF; t.perm = 0; t.item = r % I_W1; } \
        else { r -= 4 * I_W1; const int a = r / I_W2; t.W = F.mlp_w2 + (size_t)a * D * FF; t.WT = (bf16*)(F.ws + WS_W2) + (size_t)a * D * FF; t.K = FF; t.N = D; t.perm = 0; t.item = r % I_W2; } }
#define T_LOAD(t, v) { const int nblk_ = t.N / 32, k0_ = 64 * (t.item / nblk_), n0_ = 32 * (t.item % nblk_); \
        _Pragma("unroll") for (int i = 0; i < 32; ++i) { const int kk = k0_ + 2 * i + (F.lane >> 5); const int ks = t.perm ? four_slot_channel(kk) : kk; v[i] = t.W[(size_t)ks * t.N + n0_ + (F.lane & 31)]; } }
    if (gw < NITEMS) {
        TItem cur, nxt; float v[32], vn[32];
        T_DECODE(cur, gw) T_LOAD(cur, v)
#pragma unroll 1
        for (int it = gw; it < NITEMS; it += NGW) {
            const bool more = it + NGW < NITEMS;
            if (more) { T_DECODE(nxt, it + NGW) T_LOAD(nxt, vn) }
            const int nblk = cur.N / 32, k0 = 64 * (cur.item / nblk), n0 = 32 * (cur.item % nblk);
#pragma unroll
            for (int i = 0; i < 32; ++i) scr[(2 * i + (F.lane >> 5)) * 33 + (F.lane & 31)] = v[i];
            LDS_WAIT(); asm volatile("" ::: "memory");
            const int c = F.lane & 7;
#pragma unroll
            for (int jj = 0; jj < 4; ++jj) { const int n = (F.lane >> 3) + 8 * jj; const LAS float* sp = scr + (8 * c) * 33 + n;
                v4u o; o.x = pk2(sp[0 * 33], sp[1 * 33]); o.y = pk2(sp[2 * 33], sp[3 * 33]); o.z = pk2(sp[4 * 33], sp[5 * 33]); o.w = pk2(sp[6 * 33], sp[7 * 33]);
                *(v4u*)(cur.WT + (size_t)(n0 + n) * cur.K + k0 + 8 * c) = o; }
            LDS_WAIT(); asm volatile("" ::: "memory");
            if (more) { cur = nxt;
#pragma unroll
                for (int i = 0; i < 32; ++i) v[i] = vn[i]; }
        }
    }
#undef T_DECODE
#undef T_LOAD
}

template <int NR, bool CTX, bool HAS_MO, bool HAS_UX, bool XIN16, bool XOUT16>
__device__ __forceinline__ void r_rows(Frame& F, const float* xin0, const float* xin1, float* xout0, float* xout1, const bf16* mo0, const bf16* mo1, bf16* ux0, bf16* ux1,
                                       const float* sl, int nsplit, const LAS float* pr) {
    f32x4 xv0[8], xv1[8], mv0[8], mv1[8];
#pragma unroll
    for (int j = 0; j < 8; ++j) {
        if (XIN16) { const v2u w = __builtin_nontemporal_load((const v2u*)((const bf16*)xin0 + 256 * j)); xv0[j] = (f32x4){bflo(w.x), bfhi(w.x), bflo(w.y), bfhi(w.y)};
            if (NR == 2) { const v2u w1 = __builtin_nontemporal_load((const v2u*)((const bf16*)xin1 + 256 * j)); xv1[j] = (f32x4){bflo(w1.x), bfhi(w1.x), bflo(w1.y), bfhi(w1.y)}; } }
        else { xv0[j] = __builtin_nontemporal_load((const f32x4*)(xin0 + 256 * j)); if (NR == 2) xv1[j] = __builtin_nontemporal_load((const f32x4*)(xin1 + 256 * j)); } }
    if (HAS_MO) {
        if (CTX && nsplit > 0) {
#pragma unroll
            for (int j = 0; j < 8; ++j) mv0[j] = *(const f32x4*)(sl + 256 * j);
#pragma unroll 1
            for (int sp = 1; sp < nsplit; ++sp) { sl += (size_t)M_CTX * D; f32x4 t[8];
#pragma unroll
                for (int j = 0; j < 8; ++j) t[j] = *(const f32x4*)(sl + 256 * j);
#pragma unroll
                for (int j = 0; j < 8; ++j) mv0[j] += t[j]; }
        } else {
#pragma unroll
            for (int j = 0; j < 8; ++j) { const v2u w = __builtin_nontemporal_load((const v2u*)(mo0 + 256 * j)); mv0[j] = (f32x4){bflo(w.x), bfhi(w.x), bflo(w.y), bfhi(w.y)}; } }
        if (NR == 2) {
#pragma unroll
            for (int j = 0; j < 8; ++j) { const v2u w = __builtin_nontemporal_load((const v2u*)(mo1 + 256 * j)); mv1[j] = (f32x4){bflo(w.x), bfhi(w.x), bflo(w.y), bfhi(w.y)}; } }
        float s0 = 0.f, s1 = 0.f;
#pragma unroll
        for (int j = 0; j < 8; ++j) { s0 += (mv0[j].x * mv0[j].x + mv0[j].y * mv0[j].y) + (mv0[j].z * mv0[j].z + mv0[j].w * mv0[j].w);
            if (NR == 2) s1 += (mv1[j].x * mv1[j].x + mv1[j].y * mv1[j].y) + (mv1[j].z * mv1[j].z + mv1[j].w * mv1[j].w); }
        const float rstd0 = 1.0f / sqrtf(wave_sum(s0) * (1.0f / D) + NORM_EPS), rstd1 = NR == 2 ? 1.0f / sqrtf(wave_sum(s1) * (1.0f / D) + NORM_EPS) : 0.f;
#pragma unroll
        for (int j = 0; j < 8; ++j) { const f32x4 a1 = *(const LAS f32x4*)(pr + 256 * j);
            xv0[j] = xv0[j] + a1 * (mv0[j] * rstd0); if (NR == 2) xv1[j] = xv1[j] + a1 * (mv1[j] * rstd1); }
#pragma unroll
        for (int j = 0; j < 8; ++j) {
            if (XOUT16) { v2u w; w.x = pk2(xv0[j].x, xv0[j].y); w.y = pk2(xv0[j].z, xv0[j].w); __builtin_nontemporal_store(w, (v2u*)((bf16*)xout0 + 256 * j));
                if (NR == 2) { v2u w1; w1.x = pk2(xv1[j].x, xv1[j].y); w1.y = pk2(xv1[j].z, xv1[j].w); __builtin_nontemporal_store(w1, (v2u*)((bf16*)xout1 + 256 * j)); } }
            else { __builtin_nontemporal_store(xv0[j], (f32x4*)(xout0 + 256 * j)); if (NR == 2) __builtin_nontemporal_store(xv1[j], (f32x4*)(xout1 + 256 * j)); } }
    }
    if (HAS_UX) {
        float s0 = 0.f, s1 = 0.f;
#pragma unroll
        for (int j = 0; j < 8; ++j) { s0 += (xv0[j].x * xv0[j].x + xv0[j].y * xv0[j].y) + (xv0[j].z * xv0[j].z + xv0[j].w * xv0[j].w);
            if (NR == 2) s1 += (xv1[j].x * xv1[j].x + xv1[j].y * xv1[j].y) + (xv1[j].z * xv1[j].z + xv1[j].w * xv1[j].w); }
        const float rstd0 = 1.0f / sqrtf(wave_sum(s0) * (1.0f / D) + NORM_EPS), rstd1 = NR == 2 ? 1.0f / sqrtf(wave_sum(s1) * (1.0f / D) + NORM_EPS) : 0.f;
#pragma unroll
        for (int j = 0; j < 8; ++j) { const f32x4 a2 = *(const LAS f32x4*)(pr + D + 256 * j), a3 = *(const LAS f32x4*)(pr + 2 * D + 256 * j);
            { const f32x4 u = (xv0[j] * rstd0) * a2 + a3; v2u w; w.x = pk2(u.x, u.y); w.y = pk2(u.z, u.w); *(v2u*)(ux0 + 256 * j) = w; }
            if (NR == 2) { const f32x4 u = (xv1[j] * rstd1) * a2 + a3; v2u w; w.x = pk2(u.x, u.y); w.y = pk2(u.z, u.w); *(v2u*)(ux1 + 256 * j) = w; } }
    }
}

#define BF4(w) ((f32x4){bflo((w).x), bfhi((w).x), bflo((w).y), bfhi((w).y)})
template <bool HAS_MO, bool HAS_UX, bool XIN16, bool XOUT16>
__device__ __forceinline__ void r_pairs(Frame& F, const float* xsrc, float* xdst, const bf16* MO, bf16* UX, const LAS float* par, int gw, int NGW) {
    const int l4 = 4 * F.lane; const size_t pairstep = (size_t)NGW * D;
    f32x4 rxf0[8], rxf1[8]; v2u rxh0[8], rxh1[8], rm0[8], rm1[8];
#define R_LOAD(m_) { const size_t o0_ = (size_t)(m_) * D + l4, o1_ = o0_ + pairstep; \
        _Pragma("unroll") for (int j = 0; j < 8; ++j) { \
            if (XIN16) { rxh0[j] = __builtin_nontemporal_load((const v2u*)((const bf16*)xsrc + o0_ + 256 * j)); rxh1[j] = __builtin_nontemporal_load((const v2u*)((const bf16*)xsrc + o1_ + 256 * j)); } \
            else { rxf0[j] = __builtin_nontemporal_load((const f32x4*)(xsrc + o0_ + 256 * j)); rxf1[j] = __builtin_nontemporal_load((const f32x4*)(xsrc + o1_ + 256 * j)); } } \
        if (HAS_MO) { _Pragma("unroll") for (int j = 0; j < 8; ++j) { rm0[j] = __builtin_nontemporal_load((const v2u*)(MO + o0_ + 256 * j)); rm1[j] = __builtin_nontemporal_load((const v2u*)(MO + o1_ + 256 * j)); } } }
    int m0 = gw;
    if (m0 < M_TOK) R_LOAD(m0);
#pragma unroll 1
    while (m0 < M_TOK) {
        f32x4 xv0[8], xv1[8]; v2u cm0[8], cm1[8];
#pragma unroll
        for (int j = 0; j < 8; ++j) { xv0[j] = XIN16 ? BF4(rxh0[j]) : rxf0[j]; xv1[j] = XIN16 ? BF4(rxh1[j]) : rxf1[j]; if (HAS_MO) { cm0[j] = rm0[j]; cm1[j] = rm1[j]; } }
        const int mn = m0 + 2 * NGW;
        if (mn < M_TOK) R_LOAD(mn);
        const size_t o0 = (size_t)m0 * D + l4, o1 = o0 + pairstep;
        const LAS float* pr = par + (size_t)(m0 / SEQ) * 3 * D + l4;
        if (HAS_MO) {
            float s0 = 0.f, s1 = 0.f;
#pragma unroll
            for (int j = 0; j < 8; ++j) { const f32x4 a = BF4(cm0[j]), b = BF4(cm1[j]);
                s0 += (a.x * a.x + a.y * a.y) + (a.z * a.z + a.w * a.w); s1 += (b.x * b.x + b.y * b.y) + (b.z * b.z + b.w * b.w); }
            const float rstd0 = 1.0f / sqrtf(wave_sum(s0) * (1.0f / D) + NORM_EPS), rstd1 = 1.0f / sqrtf(wave_sum(s1) * (1.0f / D) + NORM_EPS);
#pragma unroll
            for (int j = 0; j < 8; ++j) { const f32x4 a1 = *(const LAS f32x4*)(pr + 256 * j);
                xv0[j] = xv0[j] + a1 * (BF4(cm0[j]) * rstd0); xv1[j] = xv1[j] + a1 * (BF4(cm1[j]) * rstd1); }
#pragma unroll
            for (int j = 0; j < 8; ++j) {
                if (XOUT16) { v2u w; w.x = pk2(xv0[j].x, xv0[j].y); w.y = pk2(xv0[j].z, xv0[j].w); __builtin_nontemporal_store(w, (v2u*)((bf16*)xdst + o0 + 256 * j));
                    v2u w1; w1.x = pk2(xv1[j].x, xv1[j].y); w1.y = pk2(xv1[j].z, xv1[j].w); __builtin_nontemporal_store(w1, (v2u*)((bf16*)xdst + o1 + 256 * j)); }
                else { __builtin_nontemporal_store(xv0[j], (f32x4*)(xdst + o0 + 256 * j)); __builtin_nontemporal_store(xv1[j], (f32x4*)(xdst + o1 + 256 * j)); } }
        }
        if (HAS_UX) {
            float s0 = 0.f, s1 = 0.f;
#pragma unroll
            for (int j = 0; j < 8; ++j) { s0 += (xv0[j].x * xv0[j].x + xv0[j].y * xv0[j].y) + (xv0[j].z * xv0[j].z + xv0[j].w * xv0[j].w);
                s1 += (xv1[j].x * xv1[j].x + xv1[j].y * xv1[j].y) + (xv1[j].z * xv1[j].z + xv1[j].w * xv1[j].w); }
            const float rstd0 = 1.0f / sqrtf(wave_sum(s0) * (1.0f / D) + NORM_EPS), rstd1 = 1.0f / sqrtf(wave_sum(s1) * (1.0f / D) + NORM_EPS);
#pragma unroll
            for (int j = 0; j < 8; ++j) { const f32x4 a2 = *(const LAS f32x4*)(pr + D + 256 * j), a3 = *(const LAS f32x4*)(pr + 2 * D + 256 * j);
                { const f32x4 u = (xv0[j] * rstd0) * a2 + a3; v2u w; w.x = pk2(u.x, u.y); w.y = pk2(u.z, u.w); *(v2u*)(UX + o0 + 256 * j) = w; }
                { const f32x4 u = (xv1[j] * rstd1) * a2 + a3; v2u w; w.x = pk2(u.x, u.y); w.y = pk2(u.z, u.w); *(v2u*)(UX + o1 + 256 * j) = w; } }
        }
        m0 = mn;
    }
#undef R_LOAD
}

template <bool HAS_MO, bool HAS_UX, bool FIRST>
__device__ __forceinline__ void r_phase_t(Frame& F, int nrows, int nsplit,
                                          const float* modg, int gate_ci, const float* gnorm,
                                          const float* modn, int sh_ci, int sc_ci, const float* gmod) {
    const int gw = F.bid * NWAVES + F.wave, NGW = F.G * NWAVES;
    const bf16* MO = (const bf16*)(F.ws + WS_MO); bf16* UX = RESID_BF16 ? (bf16*)F.out : (bf16*)(F.ws + WS_XB); float* XC = (float*)(F.ws + WS_XC);
    LAS float* par = (LAS float*)F.lds;
    {
    static_assert(D % (NWAVES * 64) == 0, "parameter fill assumes whole strides");
    constexpr int PK = D / (NWAVES * 64);
    float pg[3][PK], pn[PK], pm[PK], psc[3][PK], psh[3][PK];
#pragma unroll
    for (int k = 0; k < PK; ++k) { const int c = F.tid + k * NWAVES * 64;
        if (HAS_MO) pn[k] = gnorm[c];
        if (HAS_UX) pm[k] = gmod[c];
#pragma unroll
        for (int r = 0; r < 3; ++r) {
            if (HAS_MO) pg[r][k] = modg[(size_t)r * NMODV + gate_ci * D + c];
            if (HAS_UX) { psc[r][k] = modn[(size_t)r * NMODV + sc_ci * D + c]; psh[r][k] = modn[(size_t)r * NMODV + sh_ci * D + c]; } } }
#pragma unroll
    for (int k = 0; k < PK; ++k) { const int c = F.tid + k * NWAVES * 64;
#pragma unroll
        for (int r = 0; r < 3; ++r) {
            if (HAS_MO) par[(r * 3 + 0) * D + c] = pg[r][k] * pn[k];
            if (HAS_UX) { par[(r * 3 + 1) * D + c] = pm[k] * (1.0f + psc[r][k]); par[(r * 3 + 2) * D + c] = psh[r][k]; } } }
    }
    __syncthreads();
    const int l4 = 4 * F.lane; constexpr bool first = FIRST;
    bf16* XB = (bf16*)(F.ws + WS_XB);
    constexpr bool XIN16 = RESID_BF16 && !FIRST, XOUT16 = RESID_BF16 && HAS_UX; constexpr int SI = XIN16 ? 2 : 1, SO = XOUT16 ? 2 : 1;
    const float* xsrc = FIRST ? F.x : (XIN16 ? (const float*)XB : F.out); float* xdst = XOUT16 ? (float*)XB : F.out;
    for (int c = F.bid + F.G * F.wave; c < nrows - M_TOK; c += NGW) {
        const float* xin = (first ? F.ctx : XC) + (size_t)c * D + l4;
        r_rows<1, true, HAS_MO, HAS_UX, false, false>(F, xin, xin, XC + (size_t)c * D + l4, nullptr, MO + (size_t)(M_TOK + c) * D + l4, nullptr, UX + (size_t)(M_TOK + c) * D + l4, nullptr,
                                        (const float*)(F.ws + WS_CSP) + (size_t)c * D + l4, nsplit, par + (size_t)2 * 3 * D + l4);
    }
    if (SEQ % (2 * NGW) == 0) {
        r_pairs<HAS_MO, HAS_UX, XIN16, XOUT16>(F, xsrc, xdst, MO, UX, par, gw, NGW);
    } else {
        for (int m0 = gw; m0 < M_TOK; m0 += NGW)
            r_rows<1, false, HAS_MO, HAS_UX, XIN16, XOUT16>(F, xsrc + ((size_t)m0 * D + l4) / SI, nullptr, xdst + ((size_t)m0 * D + l4) / SO, nullptr, MO + (size_t)m0 * D + l4, nullptr, UX + (size_t)m0 * D + l4, nullptr, nullptr, 0, par + (size_t)(m0 / SEQ) * 3 * D + l4);
    }
    __syncthreads();
}
__device__ __forceinline__ void r_phase(Frame& F, int nrows, bool first, bool has_mo, bool has_ux, int nsplit,
                                        const float* modg, int gate_ci, const float* gnorm,
                                        const float* modn, int sh_ci, int sc_ci, const float* gmod) {
    if (!has_mo) r_phase_t<false, true, true>(F, nrows, nsplit, modg, gate_ci, gnorm, modn, sh_ci, sc_ci, gmod);
    else if (first) r_phase_t<true, true, true>(F, nrows, nsplit, modg, gate_ci, gnorm, modn, sh_ci, sc_ci, gmod);
    else if (has_ux) r_phase_t<true, true, false>(F, nrows, nsplit, modg, gate_ci, gnorm, modn, sh_ci, sc_ci, gmod);
    else r_phase_t<true, false, false>(F, nrows, nsplit, modg, gate_ci, gnorm, modn, sh_ci, sc_ci, gmod);
}

typedef float f32x16 __attribute__((ext_vector_type(16)));
typedef short v4i16_t __attribute__((ext_vector_type(4)));
typedef short bf16x8_t __attribute__((ext_vector_type(8)));
constexpr int AT_ROWB = 272, AT_TILEB = 64 * AT_ROWB, AT_BUFB = 2 * AT_TILEB;
__device__ __forceinline__ void attn_mfma(Frame& F, const float* sink, bool with_ctx_q) {
    const bf16* P = (const bf16*)(F.ws + WS_P); bf16* MIX = (bf16*)(F.ws + WS_Z);
    const int lane = F.lane, r = lane & 31, hlf = lane >> 5, hh = F.wave & 1, qs = F.wave >> 1;
    const int nunits = 1024 + (with_ctx_q ? 16 : 0);
    constexpr float LOG2E = 1.4426950408889634f, SC2 = ATTN_SCALE * LOG2E;
    const int c0row = F.tid >> 4, c0ch = F.tid & 15;
    const unsigned st_off0 = (unsigned)(c0row * AT_ROWB + c0ch * 16), st_off1 = st_off0 + 32u * AT_ROWB;
    const int tq = (lane & 15) >> 2, tp = lane & 3, tblk = (lane >> 4) & 1;
    const unsigned vrd = (unsigned)((4 * hlf + tq) * AT_ROWB + (2 * tblk + (tp >> 1)) * 16 + 8 * (tp & 1));
    const unsigned krd = (unsigned)(r * AT_ROWB + 16 * hlf);
    for (int u = F.bid; u < nunits; u += F.G) {
        int b, nb, kvh, gp; const bool cq = u >= 1024;
        if (!cq) { gp = u & 1; kvh = (u >> 1) & 1; nb = (u >> 2) & 127; b = u >> 9; } else { const int v = u - 1024; gp = v & 1; kvh = (v >> 1) & 1; nb = (v >> 2) & 1; b = v >> 3; }
        const int h = kvh * 4 + gp * 2 + hh;
        const size_t qrow = cq ? (size_t)M_TOK + b * CTXL + nb * 128 + qs * 32 + r : (size_t)b * SEQ + nb * 128 + qs * 32 + r;
        bf16x8_t qf[8];
#pragma unroll
        for (int ks = 0; ks < 8; ++ks) qf[ks] = *(const bf16x8_t*)(P + qrow * EIN + 1024 + h * 128 + 16 * ks + 8 * hlf);
        int jlo = 0, jhi = 6; if (cq) { jhi = 0; } else { if (nb == 0) jlo = 2; if (nb == 127) jhi = 4; }
        const int nloc = jhi - jlo, nt = nloc + 4;
        const size_t locrow0 = (size_t)b * SEQ + (size_t)(nb - 1) * 128, ctxrow0 = (size_t)M_TOK + (size_t)b * CTXL;
        const size_t kcol = 2048 + kvh * 128, vcol = 2304 + kvh * 128;
#define AT_TROW(t) ((t) < nloc ? locrow0 + 64 * (size_t)(jlo + (t)) : ctxrow0 + 64 * (size_t)((t) - nloc))
        v4u kst0, kst1, vst0, vst1;
        { const size_t tr0 = AT_TROW(0); const bf16* g0 = P + (tr0 + c0row) * EIN + c0ch * 8; const bf16* g1 = g0 + (size_t)32 * EIN;
          kst0 = *(const v4u*)(g0 + kcol); kst1 = *(const v4u*)(g1 + kcol); vst0 = *(const v4u*)(g0 + vcol); vst1 = *(const v4u*)(g1 + vcol);
          *(LAS v4u*)(F.lds + st_off0) = kst0; *(LAS v4u*)(F.lds + st_off1) = kst1; *(LAS v4u*)(F.lds + AT_TILEB + st_off0) = vst0; *(LAS v4u*)(F.lds + AT_TILEB + st_off1) = vst1; }
        if (nt > 1) { const size_t tr1 = AT_TROW(1); const bf16* g0 = P + (tr1 + c0row) * EIN + c0ch * 8; const bf16* g1 = g0 + (size_t)32 * EIN;
            kst0 = *(const v4u*)(g0 + kcol); kst1 = *(const v4u*)(g1 + kcol); vst0 = *(const v4u*)(g0 + vcol); vst1 = *(const v4u*)(g1 + vcol); }
        __syncthreads();
        f32x16 o0, o1, o2, o3;
#pragma unroll
        for (int i = 0; i < 16; ++i) { o0[i] = 0.f; o1[i] = 0.f; o2[i] = 0.f; o3[i] = 0.f; }
        float m = sink[h] * LOG2E, l = 1.0f;
        const int qi = qs * 32 + r;
        for (int t = 0; t < nt; ++t) {
            v4u kn0, kn1, vn0, vn1;
            if (t + 2 < nt) { const size_t tr2 = AT_TROW(t + 2); const bf16* g0 = P + (tr2 + c0row) * EIN + c0ch * 8; const bf16* g1 = g0 + (size_t)32 * EIN;
                kn0 = *(const v4u*)(g0 + kcol); kn1 = *(const v4u*)(g1 + kcol); vn0 = *(const v4u*)(g0 + vcol); vn1 = *(const v4u*)(g1 + vcol); }
            const LAS unsigned char* kbuf = F.lds + (t & 1) * AT_BUFB; const LAS unsigned char* vbuf = kbuf + AT_TILEB;
            const bool dead = !cq && t < nloc && ((jlo + t == 0 && qs >= 2) || (jlo + t == 5 && qs <= 1));
            if (!dead) {
            f32x16 s0, s1;
#pragma unroll
            for (int i = 0; i < 16; ++i) { s0[i] = 0.f; s1[i] = 0.f; }
#pragma unroll
            for (int ks = 0; ks < 8; ++ks) { const bf16x8_t a0 = *(const LAS bf16x8_t*)(kbuf + krd + ks * 32), a1 = *(const LAS bf16x8_t*)(kbuf + krd + 32 * AT_ROWB + ks * 32);
                s0 = __builtin_amdgcn_mfma_f32_32x32x16_bf16(a0, qf[ks], s0, 0, 0, 0); s1 = __builtin_amdgcn_mfma_f32_32x32x16_bf16(a1, qf[ks], s1, 0, 0, 0); }
            int mtype = 0, kk0 = 0;
            if (!cq && t < nloc) { const int j = jlo + t; if (j < 2) { mtype = 1; kk0 = 64 * j; } else if (j >= 4) { mtype = 2; kk0 = 64 * (j - 4); } }
            float rmx = -1e30f;
#pragma unroll
            for (int i = 0; i < 16; ++i) { const int key = (i & 3) + 8 * (i >> 2) + 4 * hlf; float a = s0[i], c = s1[i];
                if (mtype == 1) { if (kk0 + key < qi) a = -1e30f; if (kk0 + 32 + key < qi) c = -1e30f; }
                if (mtype == 2) { if (kk0 + key > qi) a = -1e30f; if (kk0 + 32 + key > qi) c = -1e30f; }
                s0[i] = a; s1[i] = c; rmx = fmaxf(rmx, fmaxf(a, c)); }
            rmx = fmaxf(rmx, shfl_xor_l(rmx, 32, lane));
            const float cand = rmx * SC2;
            if (__builtin_amdgcn_ballot_w64(cand > m + 8.0f) != 0) {
                const float mn = fmaxf(m, cand); const float alpha = __builtin_amdgcn_exp2f(m - mn); m = mn; l *= alpha;
#pragma unroll
                for (int i = 0; i < 16; ++i) { o0[i] *= alpha; o1[i] *= alpha; o2[i] *= alpha; o3[i] *= alpha; } }
            float rs = 0.f;
#pragma unroll
            for (int i = 0; i < 16; ++i) { const float a = __builtin_amdgcn_exp2f(__builtin_fmaf(s0[i], SC2, -m)), c = __builtin_amdgcn_exp2f(__builtin_fmaf(s1[i], SC2, -m)); s0[i] = a; s1[i] = c; rs += a + c; }
            rs += shfl_xor_l(rs, 32, lane);
            l += rs;
            bf16x8_t pf00, pf01, pf10, pf11;
            { v4u w; w.x = pk2(s0[0], s0[1]); w.y = pk2(s0[2], s0[3]); w.z = pk2(s0[4], s0[5]); w.w = pk2(s0[6], s0[7]); pf00 = __builtin_bit_cast(bf16x8_t, w);
              w.x = pk2(s0[8], s0[9]); w.y = pk2(s0[10], s0[11]); w.z = pk2(s0[12], s0[13]); w.w = pk2(s0[14], s0[15]); pf01 = __builtin_bit_cast(bf16x8_t, w);
              w.x = pk2(s1[0], s1[1]); w.y = pk2(s1[2], s1[3]); w.z = pk2(s1[4], s1[5]); w.w = pk2(s1[6], s1[7]); pf10 = __builtin_bit_cast(bf16x8_t, w);
              w.x = pk2(s1[8], s1[9]); w.y = pk2(s1[10], s1[11]); w.z = pk2(s1[12], s1[13]); w.w = pk2(s1[14], s1[15]); pf11 = __builtin_bit_cast(bf16x8_t, w); }
#define AT_VFRAG(dst, db, kbs) do { const v4i16_t lo_ = __builtin_amdgcn_ds_read_tr16_b64_v4i16((LAS v4i16_t*)(vbuf + vrd + (kbs) * 16 * AT_ROWB + (db) * 64)); \
                const v4i16_t hi_ = __builtin_amdgcn_ds_read_tr16_b64_v4i16((LAS v4i16_t*)(vbuf + vrd + ((kbs) * 16 + 8) * AT_ROWB + (db) * 64)); \
                dst = (bf16x8_t){lo_[0], lo_[1], lo_[2], lo_[3], hi_[0], hi_[1], hi_[2], hi_[3]}; } while (0)
#define AT_PV(oacc, db) do { bf16x8_t vf_; AT_VFRAG(vf_, db, 0); oacc = __builtin_amdgcn_mfma_f32_32x32x16_bf16(vf_, pf00, oacc, 0, 0, 0); AT_VFRAG(vf_, db, 1); oacc = __builtin_amdgcn_mfma_f32_32x32x16_bf16(vf_, pf01, oacc, 0, 0, 0); \
                AT_VFRAG(vf_, db, 2); oacc = __builtin_amdgcn_mfma_f32_32x32x16_bf16(vf_, pf10, oacc, 0, 0, 0); AT_VFRAG(vf_, db, 3); oacc = __builtin_amdgcn_mfma_f32_32x32x16_bf16(vf_, pf11, oacc, 0, 0, 0); } while (0)
            AT_PV(o0, 0); AT_PV(o1, 1); AT_PV(o2, 2); AT_PV(o3, 3);
            }
            if (t + 1 < nt) { LAS unsigned char* nb_ = F.lds + ((t + 1) & 1) * AT_BUFB;
                *(LAS v4u*)(nb_ + st_off0) = kst0; *(LAS v4u*)(nb_ + st_off1) = kst1; *(LAS v4u*)(nb_ + AT_TILEB + st_off0) = vst0; *(LAS v4u*)(nb_ + AT_TILEB + st_off1) = vst1; }
            __syncthreads();
            if (t + 2 < nt) { kst0 = kn0; kst1 = kn1; vst0 = vn0; vst1 = vn1; }
        }
        const float inv = 1.0f / l;
        bf16* orow = MIX + qrow * D + 1024 + h * 128 + 4 * hlf;
#pragma unroll
        for (int g4 = 0; g4 < 4; ++g4) { v2u w;
            w.x = pk2(o0[4 * g4] * inv, o0[4 * g4 + 1] * inv); w.y = pk2(o0[4 * g4 + 2] * inv, o0[4 * g4 + 3] * inv); *(v2u*)(orow + 0 + 8 * g4) = w;
            w.x = pk2(o1[4 * g4] * inv, o1[4 * g4 + 1] * inv); w.y = pk2(o1[4 * g4 + 2] * inv, o1[4 * g4 + 3] * inv); *(v2u*)(orow + 32 + 8 * g4) = w;
            w.x = pk2(o2[4 * g4] * inv, o2[4 * g4 + 1] * inv); w.y = pk2(o2[4 * g4 + 2] * inv, o2[4 * g4 + 3] * inv); *(v2u*)(orow + 64 + 8 * g4) = w;
            w.x = pk2(o3[4 * g4] * inv, o3[4 * g4 + 1] * inv); w.y = pk2(o3[4 * g4 + 2] * inv, o3[4 * g4 + 3] * inv); *(v2u*)(orow + 96 + 8 * g4) = w; }
#undef AT_TROW
#undef AT_VFRAG
#undef AT_PV
    }
}

__device__ __forceinline__ void attn_mfma2(Frame& F, const float* sink, bool with_ctx_q) {
    const bf16* P = (const bf16*)(F.ws + WS_P); bf16* MIX = (bf16*)(F.ws + WS_Z);
    const int lane = F.lane, r = lane & 31, hlf = lane >> 5, hh = F.wave & 1, qs = F.wave >> 1;
    const int nunits = 1024 + (with_ctx_q ? 16 : 0);
    constexpr float LOG2E = 1.4426950408889634f, SC2 = ATTN_SCALE * LOG2E;
    const int c0row = F.tid >> 4, c0ch = F.tid & 15;
    const unsigned st_off0 = (unsigned)(c0row * AT_ROWB + c0ch * 16), st_off1 = st_off0 + 32u * AT_ROWB;
    const int tq = (lane & 15) >> 2, tp = lane & 3, tblk = (lane >> 4) & 1;
    const unsigned vrd = (unsigned)((4 * hlf + tq) * AT_ROWB + (2 * tblk + (tp >> 1)) * 16 + 8 * (tp & 1));
    const unsigned krd = (unsigned)(r * AT_ROWB + 16 * hlf);
    for (int u = F.bid; u < nunits; u += F.G) {
        int b, nb, kvh, gp; const bool cq = u >= 1024;
        if (!cq) { gp = u & 1; kvh = (u >> 1) & 1; nb = (u >> 2) & 127; b = u >> 9; } else { const int v = u - 1024; gp = v & 1; kvh = (v >> 1) & 1; nb = (v >> 2) & 1; b = v >> 3; }
        const int h = kvh * 4 + gp * 2 + hh;
        const size_t qrow = cq ? (size_t)M_TOK + b * CTXL + nb * 128 + qs * 32 + r : (size_t)b * SEQ + nb * 128 + qs * 32 + r;
        bf16x8_t qf[8];
#pragma unroll
        for (int ks = 0; ks < 8; ++ks) qf[ks] = *(const bf16x8_t*)(P + qrow * EIN + 1024 + h * 128 + 16 * ks + 8 * hlf);
        int jlo = 0, jhi = 6; if (cq) { jhi = 0; } else { if (nb == 0) jlo = 2; if (nb == 127) jhi = 4; }
        const int nloc = jhi - jlo, nt = nloc + 4;
        const size_t locrow0 = (size_t)b * SEQ + (size_t)(nb - 1) * 128, ctxrow0 = (size_t)M_TOK + (size_t)b * CTXL;
        const size_t kcol = 2048 + kvh * 128, vcol = 2304 + kvh * 128;
        const int qi = qs * 32 + r;
#define AT_TROW(t) ((t) < nloc ? locrow0 + 64 * (size_t)(jlo + (t)) : ctxrow0 + 64 * (size_t)((t) - nloc))
#define AT_GP(t) (P + (AT_TROW(t) + c0row) * EIN + c0ch * 8)
#define AT_SCORE(d0, d1, kb_) do { _Pragma("unroll") for (int i = 0; i < 16; ++i) { d0[i] = 0.f; d1[i] = 0.f; } \
            _Pragma("unroll") for (int ks = 0; ks < 8; ++ks) { const bf16x8_t a0 = *(const LAS bf16x8_t*)((kb_) + krd + ks * 32), a1 = *(const LAS bf16x8_t*)((kb_) + krd + 32 * AT_ROWB + ks * 32); \
                d0 = __builtin_amdgcn_mfma_f32_32x32x16_bf16(a0, qf[ks], d0, 0, 0, 0); d1 = __builtin_amdgcn_mfma_f32_32x32x16_bf16(a1, qf[ks], d1, 0, 0, 0); } } while (0)
#define AT_MASK(d0, d1, tt) do { int mtype = 0, kk0 = 0; \
            if (!cq && (tt) < nloc) { const int j = jlo + (tt); if (j < 2) { mtype = 1; kk0 = 64 * j; } else if (j >= 4) { mtype = 2; kk0 = 64 * (j - 4); } } \
            int qd = qi - kk0 - 4 * hlf; asm volatile("" : "+v"(qd));     \
            if (mtype == 1) { _Pragma("unroll") for (int i = 0; i < 16; ++i) { const int key = (i & 3) + 8 * (i >> 2); if (key < qd) d0[i] = -1e30f; if (32 + key < qd) d1[i] = -1e30f; } } \
            if (mtype == 2) { _Pragma("unroll") for (int i = 0; i < 16; ++i) { const int key = (i & 3) + 8 * (i >> 2); if (key > qd) d0[i] = -1e30f; if (32 + key > qd) d1[i] = -1e30f; } } } while (0)
        v4u ka0, ka1, va0, va1;
        {   const bf16* g0 = AT_GP(0); const bf16* g1 = AT_GP(1);
            const v4u k00 = *(const v4u*)(g0 + kcol), k01 = *(const v4u*)(g0 + (size_t)32 * EIN + kcol), v00 = *(const v4u*)(g0 + vcol), v01 = *(const v4u*)(g0 + (size_t)32 * EIN + vcol);
            const v4u k10 = *(const v4u*)(g1 + kcol), k11 = *(const v4u*)(g1 + (size_t)32 * EIN + kcol);
            *(LAS v4u*)(F.lds + st_off0) = k00; *(LAS v4u*)(F.lds + st_off1) = k01; *(LAS v4u*)(F.lds + AT_TILEB + st_off0) = v00; *(LAS v4u*)(F.lds + AT_TILEB + st_off1) = v01;
            *(LAS v4u*)(F.lds + AT_BUFB + st_off0) = k10; *(LAS v4u*)(F.lds + AT_BUFB + st_off1) = k11; }
        __syncthreads();
        f32x16 o0, o1, o2, o3;
#pragma unroll
        for (int i = 0; i < 16; ++i) { o0[i] = 0.f; o1[i] = 0.f; o2[i] = 0.f; o3[i] = 0.f; }
        float m = sink[h] * LOG2E, l = 1.0f;
        f32x16 s0, s1;
        AT_SCORE(s0, s1, F.lds); AT_MASK(s0, s1, 0);
        __syncthreads();
        for (int t = 0; t < nt; ++t) {
            if (t + 2 < nt) { const bf16* g = AT_GP(t + 2); ka0 = *(const v4u*)(g + kcol); ka1 = *(const v4u*)(g + (size_t)32 * EIN + kcol); }
            if (t + 1 < nt) { const bf16* g = AT_GP(t + 1); va0 = *(const v4u*)(g + vcol); va1 = *(const v4u*)(g + (size_t)32 * EIN + vcol); }
            const LAS unsigned char* kbufn = F.lds + ((t + 1) & 1) * AT_BUFB; const LAS unsigned char* vbuf = F.lds + (t & 1) * AT_BUFB + AT_TILEB;
            float rmx = -1e30f;
#pragma unroll
            for (int i = 0; i < 16; ++i) rmx = fmaxf(rmx, fmaxf(s0[i], s1[i]));
            rmx = fmaxf(rmx, shfl_xor_l(rmx, 32, lane));
            const float cand = rmx * SC2;
            if (__builtin_amdgcn_ballot_w64(cand > m + 8.0f) != 0) {
                const float mn = fmaxf(m, cand); const float alpha = __builtin_amdgcn_exp2f(m - mn); m = mn; l *= alpha;
#pragma unroll
                for (int i = 0; i < 16; ++i) { o0[i] *= alpha; o1[i] *= alpha; o2[i] *= alpha; o3[i] *= alpha; } }
            f32x16 n0, n1;
            AT_SCORE(n0, n1, kbufn);
            float rs = 0.f;
#pragma unroll
            for (int i = 0; i < 16; ++i) { const float a = __builtin_amdgcn_exp2f(__builtin_fmaf(s0[i], SC2, -m)), c = __builtin_amdgcn_exp2f(__builtin_fmaf(s1[i], SC2, -m)); s0[i] = a; s1[i] = c; rs += a + c; }
            bf16x8_t pf00, pf01, pf10, pf11;
            { v4u w; w.x = pk2(s0[0], s0[1]); w.y = pk2(s0[2], s0[3]); w.z = pk2(s0[4], s0[5]); w.w = pk2(s0[6], s0[7]); pf00 = __builtin_bit_cast(bf16x8_t, w);
              w.x = pk2(s0[8], s0[9]); w.y = pk2(s0[10], s0[11]); w.z = pk2(s0[12], s0[13]); w.w = pk2(s0[14], s0[15]); pf01 = __builtin_bit_cast(bf16x8_t, w);
              w.x = pk2(s1[0], s1[1]); w.y = pk2(s1[2], s1[3]); w.z = pk2(s1[4], s1[5]); w.w = pk2(s1[6], s1[7]); pf10 = __builtin_bit_cast(bf16x8_t, w);
              w.x = pk2(s1[8], s1[9]); w.y = pk2(s1[10], s1[11]); w.z = pk2(s1[12], s1[13]); w.w = pk2(s1[14], s1[15]); pf11 = __builtin_bit_cast(bf16x8_t, w); }
#pragma unroll
            for (int ks = 0; ks < 8; ++ks) { __builtin_amdgcn_sched_group_barrier(0x100, 2, 0); __builtin_amdgcn_sched_group_barrier(0x008, 2, 0); __builtin_amdgcn_sched_group_barrier(0x002, 14, 0); }
            rs += shfl_xor_l(rs, 32, lane);
            l += rs;
#define AT_VFRAG(dst, db, kbs) do { const v4i16_t lo_ = __builtin_amdgcn_ds_read_tr16_b64_v4i16((LAS v4i16_t*)(vbuf + vrd + (kbs) * 16 * AT_ROWB + (db) * 64)); \
                const v4i16_t hi_ = __builtin_amdgcn_ds_read_tr16_b64_v4i16((LAS v4i16_t*)(vbuf + vrd + ((kbs) * 16 + 8) * AT_ROWB + (db) * 64)); \
                dst = (bf16x8_t){lo_[0], lo_[1], lo_[2], lo_[3], hi_[0], hi_[1], hi_[2], hi_[3]}; } while (0)
#define AT_PV(oacc, db) do { bf16x8_t vf_; AT_VFRAG(vf_, db, 0); oacc = __builtin_amdgcn_mfma_f32_32x32x16_bf16(vf_, pf00, oacc, 0, 0, 0); AT_VFRAG(vf_, db, 1); oacc = __builtin_amdgcn_mfma_f32_32x32x16_bf16(vf_, pf01, oacc, 0, 0, 0); \
                AT_VFRAG(vf_, db, 2); oacc = __builtin_amdgcn_mfma_f32_32x32x16_bf16(vf_, pf10, oacc, 0, 0, 0); AT_VFRAG(vf_, db, 3); oacc = __builtin_amdgcn_mfma_f32_32x32x16_bf16(vf_, pf11, oacc, 0, 0, 0); } while (0)
            AT_PV(o0, 0); AT_PV(o1, 1); AT_PV(o2, 2); AT_PV(o3, 3);
            if (t + 1 < nt) AT_MASK(n0, n1, t + 1);
            if (t + 2 < nt) { LAS unsigned char* kw = F.lds + (t & 1) * AT_BUFB; *(LAS v4u*)(kw + st_off0) = ka0; *(LAS v4u*)(kw + st_off1) = ka1; }
            if (t + 1 < nt) { LAS unsigned char* vw = F.lds + ((t + 1) & 1) * AT_BUFB + AT_TILEB; *(LAS v4u*)(vw + st_off0) = va0; *(LAS v4u*)(vw + st_off1) = va1; }
            __syncthreads();
#pragma unroll
            for (int i = 0; i < 16; ++i) { s0[i] = n0[i]; s1[i] = n1[i]; }
        }
        const float inv = 1.0f / l;
        bf16* orow = MIX + qrow * D + 1024 + h * 128 + 4 * hlf;
#pragma unroll
        for (int g4 = 0; g4 < 4; ++g4) { v2u w;
            w.x = pk2(o0[4 * g4] * inv, o0[4 * g4 + 1] * inv); w.y = pk2(o0[4 * g4 + 2] * inv, o0[4 * g4 + 3] * inv); *(v2u*)(orow + 0 + 8 * g4) = w;
            w.x = pk2(o1[4 * g4] * inv, o1[4 * g4 + 1] * inv); w.y = pk2(o1[4 * g4 + 2] * inv, o1[4 * g4 + 3] * inv); *(v2u*)(orow + 32 + 8 * g4) = w;
            w.x = pk2(o2[4 * g4] * inv, o2[4 * g4 + 1] * inv); w.y = pk2(o2[4 * g4 + 2] * inv, o2[4 * g4 + 3] * inv); *(v2u*)(orow + 64 + 8 * g4) = w;
            w.x = pk2(o3[4 * g4] * inv, o3[4 * g4 + 1] * inv); w.y = pk2(o3[4 * g4 + 2] * inv, o3[4 * g4 + 3] * inv); *(v2u*)(orow + 96 + 8 * g4) = w; }
#undef AT_TROW
#undef AT_GP
#undef AT_SCORE
#undef AT_MASK
#undef AT_VFRAG
#undef AT_PV
    }
}

__device__ __forceinline__ void conv_run(Frame& F, const bf16* GB, const bf16* ZG, bf16* AC, const LAS float* wl, int start, int len, bool head_zero, bool tail_zero) {
    const int c0 = 8 * F.lane; const v4u zero4 = {0u, 0u, 0u, 0u};
    v4u z0[4], z1[4], z2[4], z3[4], g0[4], g1[4], n1[4], n2[4], h0[4], h1[4];
#define CV_LD(dst, base, row) { const bf16* p_ = (base) + (size_t)(row) * D + c0; _Pragma("unroll") for (int j = 0; j < 4; ++j) dst[j] = __builtin_nontemporal_load((const v4u*)(p_ + 512 * j)); }
#define CV_Z0(dst) { _Pragma("unroll") for (int j = 0; j < 4; ++j) dst[j] = zero4; }
    if (head_zero) CV_Z0(z0) else CV_LD(z0, ZG, start - 1)
    CV_LD(z1, ZG, start) CV_LD(z2, ZG, start + 1)
    if (len > 2 || !tail_zero) CV_LD(z3, ZG, start + 2) else CV_Z0(z3)
    CV_LD(g0, GB, start) CV_LD(g1, GB, start + 1)
#pragma unroll 1
    for (int t = 0; t < len; t += 2) { const int m = start + t;
        if (t + 2 < len) { CV_LD(n1, ZG, m + 3) if (t + 4 < len || !tail_zero) CV_LD(n2, ZG, m + 4) else CV_Z0(n2) CV_LD(h0, GB, m + 2) CV_LD(h1, GB, m + 3) }
#pragma unroll
        for (int j = 0; j < 4; ++j) { const LAS float* wp = wl + c0 + 512 * j;
            const f32x4 w0a = *(const LAS f32x4*)(wp), w0b = *(const LAS f32x4*)(wp + 4), w1a = *(const LAS f32x4*)(wp + D), w1b = *(const LAS f32x4*)(wp + D + 4), w2a = *(const LAS f32x4*)(wp + 2 * D), w2b = *(const LAS f32x4*)(wp + 2 * D + 4);
#define CV_H(v, e) (((e) & 1) ? bfhi((v)[(e) >> 1]) : bflo((v)[(e) >> 1]))
#define CV_E(o, e, k, W0, W1, W2, G, ZA, ZB, ZC) o[e] = CV_H(G, e) * (W0[k] * CV_H(ZA, e) + W1[k] * CV_H(ZB, e) + W2[k] * CV_H(ZC, e))
#define CV_ROW(G, ZA, ZB, ZC, mrow) { float o[8]; \
                CV_E(o, 0, 0, w0a, w1a, w2a, G, ZA, ZB, ZC); CV_E(o, 1, 1, w0a, w1a, w2a, G, ZA, ZB, ZC); CV_E(o, 2, 2, w0a, w1a, w2a, G, ZA, ZB, ZC); CV_E(o, 3, 3, w0a, w1a, w2a, G, ZA, ZB, ZC); \
                CV_E(o, 4, 0, w0b, w1b, w2b, G, ZA, ZB, ZC); CV_E(o, 5, 1, w0b, w1b, w2b, G, ZA, ZB, ZC); CV_E(o, 6, 2, w0b, w1b, w2b, G, ZA, ZB, ZC); CV_E(o, 7, 3, w0b, w1b, w2b, G, ZA, ZB, ZC); \
                v4u w; w.x = pk2(o[0], o[1]); w.y = pk2(o[2], o[3]); w.z = pk2(o[4], o[5]); w.w = pk2(o[6], o[7]); *(v4u*)(AC + (size_t)(mrow) * D + c0 + 512 * j) = w; }
            CV_ROW(g0[j], z0[j], z1[j], z2[j], m) CV_ROW(g1[j], z1[j], z2[j], z3[j], m + 1)
#undef CV_ROW
#undef CV_E
#undef CV_H
        }
#pragma unroll
        for (int j = 0; j < 4; ++j) { z0[j] = z2[j]; z1[j] = z3[j]; z2[j] = n1[j]; z3[j] = n2[j]; g0[j] = h0[j]; g1[j] = h1[j]; }
    }
#undef CV_LD
#undef CV_Z0
}
__device__ __forceinline__ void conv_phase(Frame& F, const float* cw, int nrows) {
    const bf16* GB = (const bf16*)(F.ws + WS_G); const bf16* ZG = (const bf16*)(F.ws + WS_ZG); bf16* AC = (bf16*)(F.ws + WS_AC);
    const int gw = F.bid * NWAVES + F.wave, NGW = F.G * NWAVES;
    LAS float* wl = (LAS float*)F.lds;
    { float wv[3 * D / (NWAVES * 64)];
#pragma unroll
      for (int k = 0; k < 3 * D / (NWAVES * 64); ++k) wv[k] = cw[F.tid + k * NWAVES * 64];
#pragma unroll
      for (int k = 0; k < 3 * D / (NWAVES * 64); ++k) wl[F.tid + k * NWAVES * 64] = wv[k]; }
    __syncthreads();
    constexpr int RUN = 16;
    for (int ch = gw; ch < M_TOK / RUN; ch += NGW) { const int st = ch * RUN; conv_run(F, GB, ZG, AC, wl, st, RUN, st % SEQ == 0, (st + RUN) % SEQ == 0); }
    for (int c = F.bid + F.G * F.wave; c < (nrows - M_TOK) / 2; c += NGW) { const int st = M_TOK + 2 * c; conv_run(F, GB, ZG, AC, wl, st, 2, (st - M_TOK) % CTXL == 0, (st + 2 - M_TOK) % CTXL == 0); }
    __syncthreads();
}

struct Args { const float* in[15]; float* out; unsigned char* ws; int ph_lo, ph_hi; };
constexpr int PH_PER_LAYER = 16, PH_BASE = 2, PH_END = PH_BASE + DEPTH * PH_PER_LAYER;

__global__ void __launch_bounds__(NWAVES * 64, 2) dit_fwd(Args args) {
    extern __shared__ __attribute__((aligned(16))) unsigned char lds[];
    Frame F;
    F.lds = (LAS unsigned char*)lds;
    F.MISC = (volatile LAS unsigned*)(F.lds + MISC_OFF);
    F.tid = threadIdx.x; F.lane = F.tid & 63; F.wave = __builtin_amdgcn_readfirstlane(F.tid >> 6);
    F.G = gridDim.x; F.bid = blockIdx.x;
    const int wave0 = F.wave;
    F.ws = args.ws; F.out = args.out; F.ctl = (gu32*)(args.ws + WS_CTL);
    F.x = args.in[0]; F.c = args.in[1]; F.ctx = args.in[2]; F.c_ctx = args.in[3]; F.w_mod = args.in[4]; F.b_mod = args.in[5]; F.gains = args.in[6];
    F.att_w_in = args.in[7]; F.att_sink = args.in[8]; F.att_w_out = args.in[9]; F.conv_w_in = args.in[10]; F.conv_w = args.in[11]; F.conv_w_out = args.in[12];
    F.mlp_w1 = args.in[13]; F.mlp_w2 = args.in[14];
    for (int u = F.tid; u < (LDS_BYTES - LDSCTL_OFF) / 4; u += NWAVES * 64) ((LAS unsigned*)(F.lds + LDSCTL_OFF))[u] = 0u;
    __syncthreads();
    const int lo = args.ph_lo, hi = args.ph_hi;
    const bool multi = (hi - lo) > 1;
    XcdBarrier bar; bar.bar = (unsigned*)(F.ctl + CW_BAR); bar.x = 0; bar.st = nullptr;
    if (multi) bar = xcd_barrier_post((unsigned*)(F.ctl + CW_BAR), F.MISC + 8);
#define RELAUNDER() do { int ln_; asm volatile("v_mbcnt_lo_u32_b32 %0, -1, 0\n\tv_mbcnt_hi_u32_b32 %0, -1, %0" : "=v"(ln_)); int wv_ = wave0; asm volatile("" : "+s"(wv_)); F.lane = ln_; F.wave = wv_; F.tid = wv_ * 64 + ln_; } while (0)
#define IN(k) (RELAUNDER_IN(k))
#define RELAUNDER_IN(k) (lo <= (k) && (k) < hi)
#define SEAM(k) do { if (IN(k) && IN((k) + 1)) xcd_barrier(bar); } while (0)
    const float* MOD = (const float*)(F.ws + WS_MOD);
    bf16* UX = RESID_BF16 ? (bf16*)F.out : (bf16*)(F.ws + WS_XB); bf16* MO = (bf16*)(F.ws + WS_MO);

    { if (IN(0)) { p0_prologue(F, bar); } SEAM(0); }
    if (IN(1)) { r_phase(F, MT, true, false, true, 0, MOD, 0, F.gains, MOD, 0, 1, F.gains); } SEAM(1);

    for (int l = 0; l < DEPTH; ++l) {
        const int pb = PH_BASE + l * PH_PER_LAYER;
        RELAUNDER();
        const float* g = F.gains + (size_t)l * 4 * D;
        const float* modl = MOD + (size_t)l * 3 * NMODV;
        const int a = l >> 1;
        const int Mrows = l < 2 ? MT : M_TOK;
        if ((l & 1) == 0) {
            { RELAUNDER(); if (IN(pb + 0)) {
                { RELAUNDER();
                    pg8::Gemm gm = pg8::std_gemm(D); gm.hstepB = (size_t)32 * D * 2;
                    const bf16* Wt = (const bf16*)(F.ws + WS_WIN_E) + (size_t)a * D * EIN;
                    pg8::StdSched S = pg8::std_sched(UX, Wt, M_TOK, EIN, D, F.G, F.bid); S.ext_nM = M_CTX / 256;
                    pg8::EpiInEven E{(bf16*)(F.ws + WS_P), EIN, (const float*)(F.ws + WS_ROPE), M_TOK, SEQ};
                    pg8::gemm_phase<pg8::EpiInEven, pg8::StdSched, PG8_ALIGN, PG8_SP2>(F.lds + RING_OFF, gm, S, E, F.tid); } } }
            SEAM(pb + 0);
            {
            RELAUNDER(); if (IN(pb + 2)) {
                { pg8::Gemm gm; gm.K = 256; gm.pitchA = 512u; gm.hstepA = (size_t)128 * 512; gm.pitchB = 128u * EIN * 2u; gm.hstepB = (size_t)EIN * 2;
                  pg8::FaHSched S; S.init(4 * 128, F.G, F.bid); S.CM = (const char*)(F.ws + WS_DFT + DFT_CMH); S.Pb = (const char*)(F.ws + WS_P); S.pitchP = (size_t)EIN * 2; S.seq = SEQ;
                  pg8::FaHEpi E{(bf16*)(F.ws + WS_Z)};
                  pg8::gemm_phase<pg8::FaHEpi, pg8::FaHSched, PG8_ALIGN, PG8_SP2>(F.lds + RING_OFF, gm, S, E, F.tid); }
                RELAUNDER(); if (l == 0) { pg8::Gemm gm; gm.K = 256; gm.pitchA = 512u; gm.hstepA = (size_t)128 * 512; gm.pitchB = EIN * 2u; gm.hstepB = (size_t)128 * EIN * 2;
                  pg8::FaCtxSched S; S.init(8 * 2, F.G, F.bid); S.CM = (const char*)(F.ws + WS_DFT + DFT_CM); S.Pb = (const char*)(F.ws + WS_P) + (size_t)M_TOK * EIN * 2; S.pitchP = (size_t)EIN * 2;
                  pg8::FaCtxEpi E{(bf16*)(F.ws + WS_ZCTX)};
                  pg8::gemm_phase<pg8::FaCtxEpi, pg8::FaCtxSched, PG8_ALIGN, PG8_SP2>(F.lds + RING_OFF, gm, S, E, F.tid); }
            }
            SEAM(pb + 2);
            RELAUNDER(); if (IN(pb + 3)) {
                pg8::Gemm gm = pg8::std_gemm(256);
                pg8::FbSched S; S.init(516, F.G, F.bid); S.A = (const char*)(F.ws + WS_DFT + DFT_FB1); S.B = (const char*)(F.ws + WS_Z);
                pg8::FbEpi E{(bf16*)(F.ws + WS_A1), (const pg8::f32x2v*)(F.ws + WS_W16K)};
                pg8::gemm_phase<pg8::FbEpi, pg8::FbSched, PG8_ALIGN, PG8_SP2>(F.lds + RING_OFF, gm, S, E, F.tid);
            }
            SEAM(pb + 3);
            RELAUNDER(); if (IN(pb + 4)) {
                { pg8::Gemm gm; gm.K = 256; gm.pitchA = 512u; gm.hstepA = (size_t)128 * 512; gm.pitchB = 128u * 512u; gm.hstepB = (size_t)128 * 128 * 512;
                  pg8::FcSched S; S.init(640, F.G, F.bid); S.A = (const char*)(F.ws + WS_DFT + DFT_FC2); S.B = (const char*)(F.ws + WS_A1);
                  pg8::FcHEpi E{(bf16*)(F.ws + WS_Z), SEQ, D};
                  pg8::gemm_phase<pg8::FcHEpi, pg8::FcSched, PG8_ALIGN, PG8_SP2>(F.lds + RING_OFF, gm, S, E, F.tid); }
                RELAUNDER(); if (l == 0) { pg8::Gemm gm = pg8::std_gemm(512);
                  pg8::FbSched S; S.init(8, F.G, F.bid); S.A = (const char*)(F.ws + WS_DFT + DFT_F256); S.B = (const char*)(F.ws + WS_ZCTX);
                  pg8::CtxSched S2; S2.init(8, F.G, F.bid); S2.A = S.A; S2.B = S.B;
                  pg8::CtxDftEpi E{(bf16*)(F.ws + WS_Z), M_TOK, D};
                  pg8::gemm_phase<pg8::CtxDftEpi, pg8::CtxSched, PG8_ALIGN, PG8_SP2>(F.lds + RING_OFF, gm, S2, E, F.tid); }
                RELAUNDER(); attn_mfma2(F, F.att_sink + a * 8, l == 0);
            }
            SEAM(pb + 4);
            }
        } else {
            { RELAUNDER(); if (IN(pb + 0)) {
                { RELAUNDER();
                    const bf16* Wt = (const bf16*)(F.ws + WS_WIN_O) + (size_t)a * D * OIN; const bf16* Ain = UX; const int Mp = M_TOK; const size_t ro = 0; const int ext = l < 2 ? M_CTX / 256 : 0;
                    { pg8::Gemm gm = pg8::std_gemm(D); pg8::StdSched S = pg8::std_sched(Ain, Wt, Mp, D, D, F.G, F.bid); S.ext_nM = ext;
                      pg8::EpiBf16<0> E{(bf16*)(F.ws + WS_G) + ro, D};
                      pg8::gemm_phase<pg8::EpiBf16<0>, pg8::StdSched, PG8_ALIGN, PG8_SP2>(F.lds + RING_OFF, gm, S, E, F.tid); }
                    RELAUNDER();
                    { pg8::Gemm gm = pg8::std_gemm(D); gm.hstepB = (size_t)2048 * D * 2;
                      pg8::StdSched S = pg8::std_sched(Ain, Wt + (size_t)2048 * D, Mp, 16 * 256, D, F.G, F.bid); S.tsB = (size_t)128 * D * 2; S.ext_nM = ext;
                      pg8::EpiGate E{(bf16*)(F.ws + WS_ZG) + ro, D};
                      pg8::gemm_phase<pg8::EpiGate, pg8::StdSched, PG8_ALIGN, PG8_SP2>(F.lds + RING_OFF, gm, S, E, F.tid); } } } }
            SEAM(pb + 0);
            { RELAUNDER(); if (IN(pb + 1)) { conv_phase(F, F.conv_w + (size_t)a * 3 * D, Mrows); } } SEAM(pb + 1);
        }
        { RELAUNDER(); if (IN(pb + 5)) { const bf16* Ain = (l & 1) ? (const bf16*)(F.ws + WS_AC) : (const bf16*)(F.ws + WS_Z);
            const bf16* Wt = ((l & 1) ? (const bf16*)(F.ws + WS_WOUT_O) : (const bf16*)(F.ws + WS_WOUT_E)) + (size_t)a * D * D;
            { pg8::Gemm gm = pg8::std_gemm(D); pg8::StdSched S = pg8::std_sched(Ain, Wt, M_TOK, D, D, F.G, F.bid);
              pg8::EpiBf16<0> E{MO, D};
              pg8::gemm_phase<pg8::EpiBf16<0>, pg8::StdSched, PG8_ALIGN, PG8_SP2>(F.lds + RING_OFF, gm, S, E, F.tid); }
            RELAUNDER(); if (l < 2) { pg8::Gemm gm = pg8::std_gemm(D); gm.K = 256;
              pg8::SplitKSched S; S.init(8 * 2 * 8, F.G, F.bid); S.A = (const char*)(Ain + (size_t)M_TOK * D); S.B = (const char*)Wt; S.rowpitch = (size_t)D * 2; S.nN = 8; S.Kc = 256;
              pg8::EpiSlab E{(float*)(F.ws + WS_CSP), D};
              pg8::gemm_phase<pg8::EpiSlab, pg8::SplitKSched, PG8_ALIGN, PG8_SP2>(F.lds + RING_OFF, gm, S, E, F.tid); } } }
        SEAM(pb + 5);
        RELAUNDER(); if (IN(pb + 6)) { r_phase(F, Mrows, l == 0, true, true, l < 2 ? 8 : 0, modl, 2, g + D, modl, 3, 4, g + 2 * D); } SEAM(pb + 6);
        RELAUNDER(); if (IN(pb + 7)) {
            { RELAUNDER();
                pg8::Gemm gm = pg8::std_gemm(D); pg8::StdSched S = pg8::std_sched(UX, (const bf16*)(F.ws + WS_W1) + (size_t)l * D * FF, M_TOK, FF, D, F.G, F.bid); S.ext_nM = l < 2 ? M_CTX / 256 : 0;
                pg8::EpiBf16<1> E{(bf16*)(F.ws + WS_H), FF};
                pg8::gemm_phase<pg8::EpiBf16<1>, pg8::StdSched, PG8_ALIGN, PG8_SP2>(F.lds + RING_OFF, gm, S, E, F.tid); } }
        SEAM(pb + 7);
        RELAUNDER(); if (IN(pb + 8)) { const bf16* Wt = (const bf16*)(F.ws + WS_W2) + (size_t)l * D * FF;
            { pg8::Gemm gm = pg8::std_gemm(FF); pg8::StdSched S = pg8::std_sched((const bf16*)(F.ws + WS_H), Wt, M_TOK, D, FF, F.G, F.bid); S.wgm = 4; S.rev = 1;
              pg8::EpiBf16<0> E{MO, D};
              pg8::gemm_phase<pg8::EpiBf16<0>, pg8::StdSched, PG8_ALIGN, PG8_SP2>(F.lds + RING_OFF, gm, S, E, F.tid); }
            RELAUNDER(); if (l < 2) { pg8::Gemm gm = pg8::std_gemm(FF); gm.K = 512;
              pg8::SplitKSched S; S.init(16 * 2 * 8, F.G, F.bid); S.A = (const char*)((const bf16*)(F.ws + WS_H) + (size_t)M_TOK * FF); S.B = (const char*)Wt; S.rowpitch = (size_t)FF * 2; S.nN = 8; S.Kc = 512;
              pg8::EpiSlab E{(float*)(F.ws + WS_CSP), D};
              pg8::gemm_phase<pg8::EpiSlab, pg8::SplitKSched, PG8_ALIGN, PG8_SP2>(F.lds + RING_OFF, gm, S, E, F.tid); } }
        SEAM(pb + 8);
        RELAUNDER(); if (IN(pb + 9)) { const int nr = l < 2 ? MT : M_TOK; const bool ux = l < DEPTH - 1;
            r_phase(F, nr, false, true, ux, l < 2 ? 16 : 0, modl, 5, g + 3 * D, modl + 3 * NMODV, 0, 1, g + 4 * D); }
        if (l < DEPTH - 1) { if (IN(pb + 9) && IN(pb + PH_PER_LAYER)) xcd_barrier(bar); }
    }
#undef IN
#undef SEAM
}

extern "C" void kernel_launch(void* const* d_in, const int* in_sizes, int n_in, void* d_out, int out_size, void* d_ws, size_t ws_size, hipStream_t stream) {
    static int grid = 0;
    if (grid == 0) {
        if (n_in != 15 || out_size != M_TOK * D || ws_size < WS_END) { fprintf(stderr, "kernel_launch: unexpected shapes (n_in %d out %d ws %zu)\n", n_in, out_size, ws_size); grid = -1; return; }
        int dev = 0, cus = 0;
        if (hipGetDevice(&dev) != hipSuccess || hipDeviceGetAttribute(&cus, hipDeviceAttributeMultiprocessorCount, dev) != hipSuccess) { grid = -1; return; }
        if (hipFuncSetAttribute((const void*)dit_fwd, hipFuncAttributeMaxDynamicSharedMemorySize, LDS_BYTES) != hipSuccess) { fprintf(stderr, "kernel_launch: hipFuncSetAttribute failed\n"); grid = -1; return; }
        int per_cu = 0;
        if (hipOccupancyMaxActiveBlocksPerMultiprocessor(&per_cu, (const void*)dit_fwd, NWAVES * 64, LDS_BYTES) != hipSuccess || per_cu < 1) fprintf(stderr, "kernel_launch: occupancy query reports %d\n", per_cu);
        (void)hipGetLastError();
        grid = cus;
    }
    if (grid < 0) return;
    if (hipMemsetAsync((char*)d_ws + WS_CTL, 0, CTL_ZERO_BYTES, stream) != hipSuccess) return;
    Args a{};
    for (int i = 0; i < 15; ++i) a.in[i] = (const float*)d_in[i];
    a.out = (float*)d_out; a.ws = (unsigned char*)d_ws;
    a.ph_lo = 0; a.ph_hi = PH_END;
    hipLaunchKernelGGL(dit_fwd, dim3(grid), dim3(NWAVES * 64), LDS_BYTES, stream, a);
}
```

```cpp
#include <hip/hip_runtime.h>
#ifndef RESID_BF16
#define RESID_BF16 1
#endif
#include <cstdio>
#include <cstdint>


namespace pg8 {
#define PG8_LAS __attribute__((address_space(3)))
typedef unsigned short bf16_t;
typedef short bf16x8 __attribute__((ext_vector_type(8)));
typedef float f32x4 __attribute__((ext_vector_type(4)));
typedef unsigned u32x4 __attribute__((ext_vector_type(4)));
constexpr int BM = 256, BK = 64, HALF = 128, HTB = HALF * BK * 2  , STAGE_BYTES = 8 * HTB, NXCD = 8, WGM = 8;

__host__ __device__ __forceinline__ int lds_byte(int r, int c) { const int st = (r >> 4) * 2 + (c >> 5), rr = r & 15, cc = c & 31, ob = rr * 64 + cc * 2; return st * 1024 + (ob ^ (((ob >> 9) & 1) << 5)); }
__host__ __device__ __forceinline__ void stage_rc(int b, int& R, int& C) { const int st = b / 1024, sb = b % 1024, swz = sb ^ (((sb >> 9) & 1) << 5); R = (st >> 1) * 16 + swz / 64; C = (st & 1) * 32 + (swz % 64) / 2; }
__host__ __device__ __forceinline__ int perm32(int rho) { const int n = rho >> 4, i = rho & 15; return 8 * (i >> 2) + 4 * n + (i & 3); }

struct Unit { int pm, pn; };
struct Gemm { int K; unsigned pitchA, pitchB; size_t hstepA, hstepB; };

struct StaticOrder {
    int nM, nN, nwg, G, c, wgm, rev, ext_nM;
    __host__ __device__ void init(int M, int N, int G_, int c_) { nM = M / BM; nN = N / BM; nwg = nM * nN; G = G_; c = c_; wgm = WGM; rev = 0; ext_nM = 0; }
    __host__ __device__ bool next(int i, Unit& u) const {
        const long L = (long)i * G + c;
        if (L >= nwg) {
            const long L2 = L - nwg; const int nwg2 = ext_nM * nN; if (L2 >= nwg2) return false;
            int w = (int)L2; { const int q = nwg2 / NXCD, r = nwg2 % NXCD, xcd = w % NXCD, off = w / NXCD; w = (xcd < r ? xcd * (q + 1) : r * (q + 1) + (xcd - r) * q) + off; }
            u.pm = nM + w % ext_nM; u.pn = w / ext_nM; return true; }
        int wgid = (int)L; if (rev && nwg % G == 0) { const int rounds = nwg / G; wgid = (rounds - 1 - i) * G + c; }
        { const int q = nwg / NXCD, r = nwg % NXCD, xcd = wgid % NXCD, off = wgid / NXCD; wgid = (xcd < r ? xcd * (q + 1) : r * (q + 1) + (xcd - r) * q) + off; }
        const int nig = wgm * nN, gid = wgid / nig, fm = gid * wgm, gsz = (nM - fm) < wgm ? (nM - fm) : wgm;
        u.pm = fm + ((wgid % nig) % gsz); u.pn = (wgid % nig) / gsz; return true;
    }
    __device__ __forceinline__ void a_ready(const Unit&) const {}
    __device__ __forceinline__ void done(const Unit&) const {}
};


struct StdSched : StaticOrder {
    const char* A; const char* B; size_t tsA, tsB;
    __device__ __forceinline__ const char* a_ptr(const Unit& u) const { return A + (size_t)u.pm * tsA; }
    __device__ __forceinline__ const char* b_ptr(const Unit& u) const { return B + (size_t)u.pn * tsB; }
    __device__ __forceinline__ const char* a_base() const { return A; } __device__ __forceinline__ const char* b_base() const { return B; }
};
__device__ __forceinline__ Gemm std_gemm(int K) { Gemm g; g.K = K; g.pitchA = g.pitchB = (unsigned)K * 2u; g.hstepA = g.hstepB = (size_t)HALF * K * 2; return g; }
__device__ __forceinline__ StdSched std_sched(const bf16_t* A, const bf16_t* Bt, int M, int N, int K, int G, int c) { StdSched S; S.init(M, N, G, c); S.A = (const char*)A; S.B = (const char*)Bt; S.tsA = S.tsB = (size_t)BM * K * 2; return S; }
__device__ __forceinline__ unsigned cvt_pk_bf16(float lo, float hi) { unsigned r; asm volatile("v_cvt_pk_bf16_f32 %0, %1, %2" : "=v"(r) : "v"(lo), "v"(hi)); return r; }

template <int ACT  > struct EpiBf16 {
    static constexpr bool PERM = true, AFTER_DRAIN = false; static constexpr int MIN_STORES = 16;
    static __device__ __forceinline__ int brow(int R) { return (R & ~31) + perm32(R & 31); }
    bf16_t* O; int ldc;
    __device__ __forceinline__ void operator()(const f32x4 (&acc)[2][2][4][2], const Unit& u, int wr, int wc, int fr, int fq) const {
        const int row0 = u.pm * BM + wr * 64 + fr; const int col0 = u.pn * BM + wc * 32 + 8 * fq;
#pragma unroll
        for (int ai = 0; ai < 2; ++ai)
#pragma unroll
            for (int m = 0; m < 4; ++m) { bf16_t* rowp = O + (size_t)(row0 + ai * HALF + m * 16) * ldc + col0;
#pragma unroll
                for (int bj = 0; bj < 2; ++bj) { f32x4 v0 = acc[ai][bj][m][0], v1 = acc[ai][bj][m][1];
                    if (ACT == 1) {
#pragma unroll
                        for (int j = 0; j < 4; ++j) { const float a = fmaxf(v0[j], 0.f), b = fmaxf(v1[j], 0.f); v0[j] = a * a; v1[j] = b * b; } }
                    u32x4 w; w.x = cvt_pk_bf16(v0[0], v0[1]); w.y = cvt_pk_bf16(v0[2], v0[3]); w.z = cvt_pk_bf16(v1[0], v1[1]); w.w = cvt_pk_bf16(v1[2], v1[3]);
                    *(u32x4*)(rowp + bj * HALF) = w; } }
    }
};


struct EpiInEven { static constexpr int MIN_STORES = 0; static constexpr bool PERM = true, AFTER_DRAIN = false;
    static __device__ __forceinline__ int brow(int R) { const int wc = R >> 5, n = (R >> 4) & 1, fq = (R >> 2) & 3, i = R & 3; return (wc >> 1) * 128 + (wc & 1) * 64 + 8 * fq + 4 * n + i; }
    bf16_t* P; int ld; const float* rope  ; int rope_rows, seq;
    __device__ __forceinline__ void operator()(const f32x4 (&acc)[2][2][4][2], const Unit& u, int wr, int wc, int fr, int fq) const {
        const int row0 = u.pm * BM + wr * 64 + fr; const int col0 = u.pn * BM + (wc >> 1) * 128 + (wc & 1) * 64 + 8 * fq;
        const bool dorope = (u.pn >= 4 && u.pn <= 8) && (u.pm * BM < rope_rows);
#pragma unroll
        for (int ai = 0; ai < 2; ++ai)
#pragma unroll
            for (int m = 0; m < 4; ++m) { const int row = row0 + ai * HALF + m * 16; bf16_t* rowp = P + (size_t)row * ld + col0;
                f32x4 a0 = acc[ai][0][m][0], a1 = acc[ai][0][m][1], b0 = acc[ai][1][m][0], b1 = acc[ai][1][m][1];
                if (dorope) { const int t = row % seq, pos = (wc & 1) ? (t & 63) : (t >> 6); const f32x4* cs = (const f32x4*)(rope + ((size_t)pos * 32 + 8 * fq) * 2);
                    const f32x4 c0 = cs[0], c1 = cs[1], c2 = cs[2], c3 = cs[3];
                    f32x4 x0, x1, y0, y1;
                    x0[0] = a0[0] * c0[0] - b0[0] * c0[1]; y0[0] = b0[0] * c0[0] + a0[0] * c0[1]; x0[1] = a0[1] * c0[2] - b0[1] * c0[3]; y0[1] = b0[1] * c0[2] + a0[1] * c0[3];
                    x0[2] = a0[2] * c1[0] - b0[2] * c1[1]; y0[2] = b0[2] * c1[0] + a0[2] * c1[1]; x0[3] = a0[3] * c1[2] - b0[3] * c1[3]; y0[3] = b0[3] * c1[2] + a0[3] * c1[3];
                    x1[0] = a1[0] * c2[0] - b1[0] * c2[1]; y1[0] = b1[0] * c2[0] + a1[0] * c2[1]; x1[1] = a1[1] * c2[2] - b1[1] * c2[3]; y1[1] = b1[1] * c2[2] + a1[1] * c2[3];
                    x1[2] = a1[2] * c3[0] - b1[2] * c3[1]; y1[2] = b1[2] * c3[0] + a1[2] * c3[1]; x1[3] = a1[3] * c3[2] - b1[3] * c3[3]; y1[3] = b1[3] * c3[2] + a1[3] * c3[3];
                    a0 = x0; a1 = x1; b0 = y0; b1 = y1; }
                u32x4 w; w.x = cvt_pk_bf16(a0[0], a0[1]); w.y = cvt_pk_bf16(a0[2], a0[3]); w.z = cvt_pk_bf16(a1[0], a1[1]); w.w = cvt_pk_bf16(a1[2], a1[3]); *(u32x4*)rowp = w;
                w.x = cvt_pk_bf16(b0[0], b0[1]); w.y = cvt_pk_bf16(b0[2], b0[3]); w.z = cvt_pk_bf16(b1[0], b1[1]); w.w = cvt_pk_bf16(b1[2], b1[3]); *(u32x4*)(rowp + 32) = w; }
    } };


struct LinOrder { int nwg, G, c; __device__ __forceinline__ void init(int n, int G_, int c_) { nwg = n; G = G_; c = c_; }
    __device__ __forceinline__ bool nextL(int i, int& L) const { const long x = (long)i * G + c; if (x >= nwg) return false; L = (int)x; return true; }
    __device__ __forceinline__ void a_ready(const Unit&) const {} __device__ __forceinline__ void done(const Unit&) const {} };
struct SplitKSched : LinOrder { const char* A; const char* B; size_t rowpitch; int nN, Kc;
    __device__ __forceinline__ bool next(int i, Unit& u) const { int L; if (!nextL(i, L)) return false; u.pn = L % nN; const int q = L / nN; u.pm = q; return true; }
    __device__ __forceinline__ const char* a_ptr(const Unit& u) const { return A + (size_t)(u.pm & 1) * 256 * rowpitch + (size_t)(u.pm >> 1) * Kc * 2; }
    __device__ __forceinline__ const char* b_ptr(const Unit& u) const { return B + (size_t)u.pn * 256 * rowpitch + (size_t)(u.pm >> 1) * Kc * 2; }
    __device__ __forceinline__ const char* a_base() const { return A; } __device__ __forceinline__ const char* b_base() const { return B; } };
struct EpiSlab { static constexpr int MIN_STORES = 0; static constexpr bool PERM = false, AFTER_DRAIN = false; static __device__ __forceinline__ int brow(int R) { return R; }
    float* slab; int ldc;
    __device__ __forceinline__ void operator()(const f32x4 (&acc)[2][2][4][2], const Unit& u, int wr, int wc, int fr, int fq) const {
        const int row0 = (u.pm >> 1) * 512 + (u.pm & 1) * 256 + wr * 64 + fr, col0 = u.pn * BM + wc * 32 + 4 * fq;
#pragma unroll
        for (int ai = 0; ai < 2; ++ai)
#pragma unroll
            for (int m = 0; m < 4; ++m) { float* rowp = slab + (size_t)(row0 + ai * HALF + m * 16) * ldc + col0;
#pragma unroll
                for (int bj = 0; bj < 2; ++bj)
#pragma unroll
                    for (int n = 0; n < 2; ++n) *(f32x4*)(rowp + bj * HALF + n * 16) = acc[ai][bj][m][n]; }
    } };


struct EpiGate { static constexpr int MIN_STORES = 0; static constexpr bool PERM = true, AFTER_DRAIN = false; static __device__ __forceinline__ int brow(int R) { return (R & ~31) + perm32(R & 31); }
    bf16_t* Z; int ld;
    __device__ __forceinline__ void operator()(const f32x4 (&acc)[2][2][4][2], const Unit& u, int wr, int wc, int fr, int fq) const {
        const int row0 = u.pm * BM + wr * 64 + fr; const int col0 = u.pn * HALF + wc * 32 + 8 * fq;
#pragma unroll
        for (int ai = 0; ai < 2; ++ai)
#pragma unroll
            for (int m = 0; m < 4; ++m) { const f32x4 z0 = acc[ai][0][m][0] * acc[ai][1][m][0], z1 = acc[ai][0][m][1] * acc[ai][1][m][1];
                u32x4 w; w.x = cvt_pk_bf16(z0[0], z0[1]); w.y = cvt_pk_bf16(z0[2], z0[3]); w.z = cvt_pk_bf16(z1[0], z1[1]); w.w = cvt_pk_bf16(z1[2], z1[3]);
                *(u32x4*)(Z + (size_t)(row0 + ai * HALF + m * 16) * ld + col0) = w; }
    } };

struct FaCtxSched : LinOrder { const char* CM; const char* Pb; size_t pitchP;
    __device__ __forceinline__ bool next(int i, Unit& u) const { int L; if (!nextL(i, L)) return false; u.pm = L & 7; u.pn = L >> 3; return true; }
    __device__ __forceinline__ const char* a_ptr(const Unit& u) const { return CM + (size_t)(u.pm & 1) * 256 * 512; }
    __device__ __forceinline__ const char* b_ptr(const Unit& u) const { return Pb + (size_t)u.pn * 256 * pitchP + (size_t)(u.pm >> 1) * 512; }
    __device__ __forceinline__ const char* a_base() const { return CM; } __device__ __forceinline__ const char* b_base() const { return Pb; } };
struct FaCtxEpi { static constexpr int MIN_STORES = 0; static constexpr bool PERM = true, AFTER_DRAIN = false; static __device__ __forceinline__ int brow(int R) { return (R & ~31) + perm32(R & 31); } bf16_t* ZcCtx;
    __device__ __forceinline__ void operator()(const f32x4 (&acc)[2][2][4][2], const Unit& u, int wr, int wc, int fr, int fq) const {
        const int g = u.pm >> 1, ri = u.pm & 1, b = u.pn;
#pragma unroll
        for (int ai = 0; ai < 2; ++ai)
#pragma unroll
            for (int m = 0; m < 4; ++m) { const int j = 128 * ai + 64 * wr + 16 * m + fr;
#pragma unroll
                for (int bj = 0; bj < 2; ++bj) { const f32x4 v0 = acc[ai][bj][m][0], v1 = acc[ai][bj][m][1];
                    u32x4 w; w.x = cvt_pk_bf16(v0[0], v0[1]); w.y = cvt_pk_bf16(v0[2], v0[3]); w.z = cvt_pk_bf16(v1[0], v1[1]); w.w = cvt_pk_bf16(v1[2], v1[3]);
                    *(u32x4*)(ZcCtx + (((size_t)((b * 4 + g) * 256 + j) * 2 + ri) * 256 + 128 * bj + 32 * wc + 8 * fq)) = w; } }
    } };
struct FbSched : LinOrder { const char* A; const char* B;
    __device__ __forceinline__ bool next(int i, Unit& u) const { int L; if (!nextL(i, L)) return false; u.pm = 0; u.pn = L; return true; }
    __device__ __forceinline__ const char* a_ptr(const Unit&) const { return A; }
    __device__ __forceinline__ const char* b_ptr(const Unit& u) const { return B + (size_t)u.pn * 256 * 512; }
    __device__ __forceinline__ const char* a_base() const { return A; } __device__ __forceinline__ const char* b_base() const { return B; } };
typedef float f32x2v __attribute__((ext_vector_type(2)));
struct FbEpi { static constexpr int MIN_STORES = 0; static constexpr bool PERM = true, AFTER_DRAIN = false; static __device__ __forceinline__ int brow(int R) { return (R & ~31) + perm32(R & 31); } bf16_t* A1c; const f32x2v* w16k;
    __device__ __forceinline__ void operator()(const f32x4 (&acc)[2][2][4][2], const Unit& u, int wr, int wc, int fr, int fq) const {
        const int t20 = 32 * wc + 8 * fq;
        f32x2v t0s[4], sts[4];
#pragma unroll
        for (int m = 0; m < 4; ++m) { const int k1 = 64 * wr + 16 * m + fr; t0s[m] = w16k[(k1 * t20) & 16383]; sts[m] = w16k[k1]; }
#pragma unroll
        for (int m = 0; m < 4; ++m) { const int k1 = 64 * wr + 16 * m + fr; const f32x2v t0 = t0s[m], st = sts[m];
            bf16_t* dst0 = A1c + (((size_t)u.pn * 2 * 128 + k1) * 2) * 128 + t20; bf16_t* dst1 = dst0 + (size_t)128 * 2 * 128;
            float cx = t0.x, cy = t0.y; u32x4 wr0, wi0, wr1, wi1; float pr0 = 0.f, pi0 = 0.f, pr1 = 0.f, pi1 = 0.f;
#pragma unroll
            for (int e = 0; e < 8; ++e) { const float ar0 = acc[0][0][m][e >> 2][e & 3], ai0 = acc[1][0][m][e >> 2][e & 3], ar1 = acc[0][1][m][e >> 2][e & 3], ai1 = acc[1][1][m][e >> 2][e & 3];
                const float br0 = ar0 * cx + ai0 * cy, bi0 = ai0 * cx - ar0 * cy, br1 = ar1 * cx + ai1 * cy, bi1 = ai1 * cx - ar1 * cy;
                if (e & 1) { wr0[e >> 1] = cvt_pk_bf16(pr0, br0); wi0[e >> 1] = cvt_pk_bf16(pi0, bi0); wr1[e >> 1] = cvt_pk_bf16(pr1, br1); wi1[e >> 1] = cvt_pk_bf16(pi1, bi1); }
                else { pr0 = br0; pi0 = bi0; pr1 = br1; pi1 = bi1; }
                const float nx = cx * st.x - cy * st.y, ny = cx * st.y + cy * st.x; cx = nx; cy = ny; }
            *(u32x4*)dst0 = wr0; *(u32x4*)(dst0 + 128) = wi0; *(u32x4*)dst1 = wr1; *(u32x4*)(dst1 + 128) = wi1;
            asm volatile("" ::: "memory"); }
    } };
struct FcSched : LinOrder { const char* A; const char* B;
    __device__ __forceinline__ bool next(int i, Unit& u) const { int L; if (!nextL(i, L)) return false; u.pm = L & 127; u.pn = L >> 7; return true; }
    __device__ __forceinline__ const char* a_ptr(const Unit&) const { return A; }
    __device__ __forceinline__ const char* b_ptr(const Unit& u) const { return B + ((size_t)u.pn * 256 * 128 + u.pm) * 512; }
    __device__ __forceinline__ const char* a_base() const { return A; } __device__ __forceinline__ const char* b_base() const { return B; } };
struct CtxSched : LinOrder { const char* A; const char* B;
    __device__ __forceinline__ bool next(int i, Unit& u) const { int L; if (!nextL(i, L)) return false; u.pm = 0; u.pn = L; return true; }
    __device__ __forceinline__ const char* a_ptr(const Unit&) const { return A; }
    __device__ __forceinline__ const char* b_ptr(const Unit& u) const { return B + (size_t)u.pn * 256 * 1024; }
    __device__ __forceinline__ const char* a_base() const { return A; } __device__ __forceinline__ const char* b_base() const { return B; } };
struct CtxDftEpi { static constexpr int MIN_STORES = 0; static constexpr bool PERM = true, AFTER_DRAIN = false; static __device__ __forceinline__ int brow(int R) { return (R & ~31) + perm32(R & 31); } bf16_t* MIXp; int row0, ld;
    __device__ __forceinline__ void operator()(const f32x4 (&acc)[2][2][4][2], const Unit& u, int wr, int wc, int fr, int fq) const {
        const int b = u.pn >> 2, g = u.pn & 3;
#pragma unroll
        for (int ai = 0; ai < 2; ++ai)
#pragma unroll
            for (int m = 0; m < 4; ++m) { const int k = 128 * ai + 64 * wr + 16 * m + fr; bf16_t* rowp = MIXp + ((size_t)row0 + b * 256 + k) * ld + g * 256;
#pragma unroll
                for (int bj = 0; bj < 2; ++bj) { const f32x4 v0 = acc[ai][bj][m][0] * (1.0f / 256.0f), v1 = acc[ai][bj][m][1] * (1.0f / 256.0f); const int j0 = 128 * bj + 32 * wc + 8 * fq;
                    u32x4 w; w.x = cvt_pk_bf16(v0[0], v0[1]); w.y = cvt_pk_bf16(v0[2], v0[3]); w.z = cvt_pk_bf16(v1[0], v1[1]); w.w = cvt_pk_bf16(v1[2], v1[3]);
                    if (bj == 0) *(u32x4*)(rowp + j0) = w;
                    else {
#pragma unroll
                        for (int e = 0; e < 8; ++e) { const int c = j0 + e, sl = c == 128 ? 128 : 384 - c; const unsigned ww = e < 2 ? w.x : (e < 4 ? w.y : (e < 6 ? w.z : w.w)); rowp[sl] = (bf16_t)((e & 1) ? (ww >> 16) : (ww & 0xffffu)); } } } }
    } };


struct FaHSched : LinOrder { const char* CM; const char* Pb; size_t pitchP; int seq;
    __device__ __forceinline__ bool next(int i, Unit& u) const { int L; if (!nextL(i, L)) return false; u.pm = L & 3; u.pn = L >> 2; return true; }
    __device__ __forceinline__ const char* a_ptr(const Unit&) const { return CM; }
    __device__ __forceinline__ const char* b_ptr(const Unit& u) const { const int b = u.pn >> 6, t2 = 2 * (u.pn & 63); return Pb + ((size_t)b * seq + t2) * pitchP + (size_t)u.pm * 512; }
    __device__ __forceinline__ const char* a_base() const { return CM; } __device__ __forceinline__ const char* b_base() const { return Pb; } };
struct FaHEpi { static constexpr int MIN_STORES = 0; static constexpr bool PERM = true, AFTER_DRAIN = false; static __device__ __forceinline__ int brow(int R) { return (R & ~31) + perm32(R & 31); } bf16_t* Zc;
    __device__ __forceinline__ void operator()(const f32x4 (&acc)[2][2][4][2], const Unit& u, int wr, int wc, int fr, int fq) const {
        const int g = u.pm, b = u.pn >> 6, t2p = 2 * (u.pn & 63), bg = b * 4 + g;
#pragma unroll
        for (int ai = 0; ai < 2; ++ai)
#pragma unroll
            for (int m = 0; m < 4; ++m) { const int j = 64 * wr + 16 * m + fr;
#pragma unroll
                for (int bj = 0; bj < 2; ++bj) { const f32x4 v0 = acc[ai][bj][m][0], v1 = acc[ai][bj][m][1];
                    u32x4 w; w.x = cvt_pk_bf16(v0[0], v0[1]); w.y = cvt_pk_bf16(v0[2], v0[3]); w.z = cvt_pk_bf16(v1[0], v1[1]); w.w = cvt_pk_bf16(v1[2], v1[3]);
                    const size_t t2 = (size_t)(t2p + bj), t10 = 32 * wc + 8 * fq;
                    if (ai == 1 && j == 0) {
                        const u32x4 z = {0u, 0u, 0u, 0u};
                        *(u32x4*)(Zc + ((((size_t)(1024 + bg) * 128 + t2) * 2 + 0) * 128 + t10)) = w; *(u32x4*)(Zc + ((((size_t)(1024 + bg) * 128 + t2) * 2 + 1) * 128 + t10)) = z;
                        *(u32x4*)(Zc + ((((size_t)(bg * 128) * 128 + t2) * 2 + 1) * 128 + t10)) = z;
                    } else *(u32x4*)(Zc + ((((size_t)(bg * 128 + j) * 128 + t2) * 2 + ai) * 128 + t10)) = w; } }
    } };
struct FcHEpi { static constexpr int MIN_STORES = 0; static constexpr bool PERM = true, AFTER_DRAIN = false; static __device__ __forceinline__ int brow(int R) { return (R & ~31) + perm32(R & 31); } bf16_t* MIXp; int seq, ld;
    __device__ __forceinline__ void operator()(const f32x4 (&acc)[2][2][4][2], const Unit& u, int wr, int wc, int fr, int fq) const {
        const int k1 = u.pm;
#pragma unroll
        for (int m = 0; m < 4; ++m) { const int k2 = 64 * wr + 16 * m + fr, k = k1 + 128 * k2, km = (seq - k) & (seq - 1);
            if (u.pn < 4) {
#pragma unroll
                for (int bj = 0; bj < 2; ++bj) { const int bg = 2 * u.pn + bj, b = bg >> 2, g = bg & 3, j0 = 32 * wc + 8 * fq;
                    const f32x4 v0 = acc[0][bj][m][0] * (1.0f / 2048.0f), v1 = acc[0][bj][m][1] * (1.0f / 2048.0f);
                    u32x4 w; w.x = cvt_pk_bf16(v0[0], v0[1]); w.y = cvt_pk_bf16(v0[2], v0[3]); w.z = cvt_pk_bf16(v1[0], v1[1]); w.w = cvt_pk_bf16(v1[2], v1[3]);
                    *(u32x4*)(MIXp + ((size_t)b * seq + k) * ld + g * 256 + j0) = w;
                    bf16_t* mp = MIXp + ((size_t)b * seq + km) * ld + g * 256 + 128 + j0;
                    if (j0 != 0) *(u32x4*)mp = w;
                    else { mp[1] = (bf16_t)(w.x >> 16); *(unsigned*)(mp + 2) = w.y; *(unsigned long long*)(mp + 4) = ((unsigned long long)w.w << 32) | w.z; } }
            } else if (wc == 0 && fq == 0) {
                const f32x4 v0 = acc[0][0][m][0] * (1.0f / 2048.0f), v1 = acc[0][0][m][1] * (1.0f / 2048.0f);
#pragma unroll
                for (int e = 0; e < 8; ++e) { const float y = e < 4 ? v0[e & 3] : v1[e & 3]; MIXp[((size_t)(e >> 2) * seq + k) * ld + (e & 3) * 256 + 128] = (bf16_t)(cvt_pk_bf16(y, 0.f) & 0xffffu); }
            } }
    } };

template <class Epi, class Sched, bool ALIGN_EPI = false, bool SP2 = false>
__device__ __forceinline__ void gemm_phase(PG8_LAS unsigned char* lds, const Gemm g, const Sched& S, const Epi& E, const int tid) {
    const int wid = __builtin_amdgcn_readfirstlane(tid >> 6), lane = tid & 63, wr = wid >> 2, wc = wid & 3, fr = lane & 15, fq = lane >> 4;
    int Kl = g.K; asm volatile("" : "+s"(Kl));
    const int nt = Kl / BK;
    unsigned voffA[2], voffB[2];
#pragma unroll
    for (int i = 0; i < 2; ++i) { int R, C; stage_rc(tid * 16 + i * 8192, R, C); const int Rb = Epi::brow(R);
        voffA[i] = (unsigned)R * g.pitchA + (unsigned)C * 2u; voffB[i] = (unsigned)Rb * g.pitchB + (unsigned)C * 2u; }
    const unsigned kstep = (unsigned)(BK * 2);
    const unsigned hstepA = (unsigned)g.hstepA, hstepB = (unsigned)g.hstepB;
    const char* const baseA = S.a_base(); const char* const baseB = S.b_base();
    const __amdgpu_buffer_rsrc_t rs_voffA = __builtin_amdgcn_make_buffer_rsrc((void*)baseA, 0, 0x7fffffff, 0x00020000);
    const __amdgpu_buffer_rsrc_t rs_voffB = __builtin_amdgcn_make_buffer_rsrc((void*)baseB, 0, 0x7fffffff, 0x00020000);
    const unsigned ldsw = (unsigned)wid * 1024u;
    const int aoff = lds_byte(wr * 64 + fr, fq * 8), boff = lds_byte(wc * 32 + fr, fq * 8);
#define PG8_SA(b, h) (((b) * 2 + (h)) * HTB)
#define PG8_SB(b, h) ((4 + (b) * 2 + (h)) * HTB)
#define PG8_STAGE(bufoff, goff, voff) do { _Pragma("unroll") for (int _i = 0; _i < 2; ++_i) \
        __builtin_amdgcn_raw_ptr_buffer_load_lds(rs_##voff, (PG8_LAS unsigned*)(lds + (bufoff) + ldsw + _i * 8192), 16, (voff)[_i], (goff), 0, 0); } while (0)
#define PG8_LDA(dst, b, h) do { _Pragma("unroll") for (int m = 0; m < 4; ++m) _Pragma("unroll") for (int k = 0; k < 2; ++k) dst[m][k] = *(const PG8_LAS bf16x8*)(lds + PG8_SA(b, h) + aoff + m * 2048 + k * 1024); } while (0)
#define PG8_LDB(dst, b, h) do { _Pragma("unroll") for (int n = 0; n < 2; ++n) _Pragma("unroll") for (int k = 0; k < 2; ++k) dst[n][k] = *(const PG8_LAS bf16x8*)(lds + PG8_SB(b, h) + boff + n * 2048 + k * 1024); } while (0)
#define PG8_MMA(ai, bj, At, Bt) do { __builtin_amdgcn_s_setprio(1); _Pragma("unroll") for (int m = 0; m < 4; ++m) _Pragma("unroll") for (int n = 0; n < 2; ++n) _Pragma("unroll") for (int k = 0; k < 2; ++k) \
        acc[ai][bj][m][n] = __builtin_amdgcn_mfma_f32_16x16x32_bf16(Bt[n][k], At[m][k], acc[ai][bj][m][n], 0, 0, 0); __builtin_amdgcn_s_setprio(0); } while (0)
#define PG8_WAIT_V(n) asm volatile("s_waitcnt vmcnt(" #n ")" ::: "memory")
#define PG8_WAIT_L(n) asm volatile("s_waitcnt lgkmcnt(" #n ")" ::: "memory")
#define PG8_BAR __builtin_amdgcn_s_barrier()
#define PG8_SCHED __builtin_amdgcn_sched_barrier(0)
    Unit cur, nxt; int ui = 0;
    if (!S.next(0, cur)) return;
    f32x4 acc[2][2][4][2];
#pragma unroll
    for (int a = 0; a < 2; ++a)
#pragma unroll
        for (int b = 0; b < 2; ++b)
#pragma unroll
            for (int m = 0; m < 4; ++m)
#pragma unroll
                for (int n = 0; n < 2; ++n) acc[a][b][m][n] = (f32x4){0.f, 0.f, 0.f, 0.f};
    bf16x8 At[4][2], B0[2][2], B1[2][2];
    unsigned cA = (unsigned)(S.a_ptr(cur) - baseA), cB = (unsigned)(S.b_ptr(cur) - baseB);
    S.a_ready(cur);
    if constexpr (SP2) {
        PG8_STAGE(PG8_SB(0, 0), cB, voffB); PG8_STAGE(PG8_SB(0, 1), cB + hstepB, voffB); PG8_STAGE(PG8_SA(0, 0), cA, voffA); PG8_STAGE(PG8_SA(0, 1), cA + hstepA, voffA);
        if (wr == 1) PG8_BAR;
        PG8_WAIT_V(2); PG8_BAR;
        PG8_STAGE(PG8_SB(1, 0), cB + kstep, voffB); PG8_STAGE(PG8_SA(1, 0), cA + kstep, voffA); PG8_STAGE(PG8_SB(1, 1), cB + hstepB + kstep, voffB);
        PG8_WAIT_V(6); PG8_BAR;
    } else {
        PG8_STAGE(PG8_SB(0, 0), cB, voffB); PG8_STAGE(PG8_SA(0, 0), cA, voffA); PG8_STAGE(PG8_SB(0, 1), cB + hstepB, voffB); PG8_STAGE(PG8_SA(0, 1), cA + hstepA, voffA);
        if (wr == 1) PG8_BAR;
        PG8_WAIT_V(4); PG8_BAR;
        PG8_STAGE(PG8_SB(1, 0), cB + kstep, voffB); PG8_STAGE(PG8_SA(1, 0), cA + kstep, voffA); PG8_STAGE(PG8_SB(1, 1), cB + hstepB + kstep, voffB);
        PG8_WAIT_V(6); PG8_BAR;
    }
    for (;;) {
        const bool has_next = S.next(ui + 1, nxt);
        const unsigned nA = has_next ? (unsigned)(S.a_ptr(nxt) - baseA) : cA, nB = has_next ? (unsigned)(S.b_ptr(nxt) - baseB) : cB;
        for (int t = 0; t < nt; t += 2) {
            const bool last = (t == nt - 2);
            const unsigned a1 = cA + (unsigned)(t + 1) * kstep;
            const unsigned a2 = last ? nA : cA + (unsigned)(t + 2) * kstep, b2 = last ? nB : cB + (unsigned)(t + 2) * kstep;
            const unsigned a3 = a2 + kstep, b3 = b2 + kstep;
            if (last && has_next) S.a_ready(nxt);
            if constexpr (SP2) {
            const bool relax = Epi::MIN_STORES >= 16 && ui > 0 && t == 0;
            PG8_LDB(B0, 0, 0); PG8_LDB(B1, 0, 1); PG8_SCHED; PG8_LDA(At, 0, 0); PG8_STAGE(PG8_SA(1, 1), a1 + hstepA, voffA);
            if (relax) PG8_WAIT_V(24); else PG8_WAIT_V(8);
            PG8_WAIT_L(0); PG8_BAR; PG8_MMA(0, 0, At, B0); PG8_MMA(0, 1, At, B1); PG8_BAR; PG8_SCHED;
            PG8_LDA(At, 0, 1); PG8_STAGE(PG8_SB(0, 0), b2, voffB); PG8_STAGE(PG8_SB(0, 1), b2 + hstepB, voffB); PG8_STAGE(PG8_SA(0, 0), a2, voffA);
            if (relax) PG8_WAIT_V(24); else PG8_WAIT_V(8);
            PG8_WAIT_L(0); PG8_BAR; PG8_MMA(1, 0, At, B0); PG8_MMA(1, 1, At, B1); PG8_BAR; PG8_SCHED;
            PG8_LDB(B0, 1, 0); PG8_LDB(B1, 1, 1); PG8_SCHED; PG8_LDA(At, 1, 0); PG8_STAGE(PG8_SA(0, 1), a2 + hstepA, voffA);
            PG8_WAIT_V(8); PG8_WAIT_L(0); PG8_BAR; PG8_MMA(0, 0, At, B0); PG8_MMA(0, 1, At, B1); PG8_BAR; PG8_SCHED;
            PG8_LDA(At, 1, 1); PG8_STAGE(PG8_SB(1, 0), b3, voffB); PG8_STAGE(PG8_SB(1, 1), b3 + hstepB, voffB); PG8_STAGE(PG8_SA(1, 0), a3, voffA);
            PG8_WAIT_V(8); PG8_WAIT_L(0); PG8_BAR; PG8_MMA(1, 0, At, B0); PG8_MMA(1, 1, At, B1); PG8_BAR; PG8_SCHED;
            } else {
            PG8_LDB(B0, 0, 0); PG8_SCHED; PG8_LDA(At, 0, 0); PG8_STAGE(PG8_SA(1, 1), a1 + hstepA, voffA);
            PG8_WAIT_L(8); PG8_BAR; PG8_WAIT_L(0); PG8_MMA(0, 0, At, B0); PG8_BAR; PG8_SCHED;
            PG8_LDB(B1, 0, 1); PG8_STAGE(PG8_SB(0, 0), b2, voffB);
            PG8_BAR; PG8_WAIT_L(0); PG8_MMA(0, 1, At, B1); PG8_BAR;
            PG8_LDA(At, 0, 1); PG8_STAGE(PG8_SA(0, 0), a2, voffA);
            PG8_BAR; PG8_WAIT_L(0); PG8_MMA(1, 0, At, B0); PG8_BAR; PG8_SCHED;
            PG8_STAGE(PG8_SB(0, 1), b2 + hstepB, voffB);
            PG8_WAIT_V(6); PG8_BAR; PG8_MMA(1, 1, At, B1); PG8_BAR;
            PG8_LDB(B0, 1, 0); PG8_SCHED; PG8_LDA(At, 1, 0); PG8_STAGE(PG8_SA(0, 1), a2 + hstepA, voffA);
            PG8_WAIT_L(8); PG8_BAR; PG8_WAIT_L(0); PG8_MMA(0, 0, At, B0); PG8_BAR; PG8_SCHED;
            PG8_LDB(B1, 1, 1); PG8_STAGE(PG8_SB(1, 0), b3, voffB);
            PG8_BAR; PG8_WAIT_L(0); PG8_MMA(0, 1, At, B1); PG8_BAR;
            PG8_LDA(At, 1, 1); PG8_STAGE(PG8_SA(1, 0), a3, voffA);
            PG8_BAR; PG8_WAIT_L(0); PG8_MMA(1, 0, At, B0); PG8_BAR; PG8_SCHED;
            PG8_STAGE(PG8_SB(1, 1), b3 + hstepB, voffB);
            PG8_WAIT_V(6); PG8_BAR; PG8_MMA(1, 1, At, B1); PG8_BAR;
            }
        }
        if constexpr (ALIGN_EPI) { if (wr == 0) PG8_BAR; }
        if constexpr (!Epi::AFTER_DRAIN) { E(acc, cur, wr, wc, fr, fq); S.done(cur); }
        if (!has_next) break;
#pragma unroll
        for (int a = 0; a < 2; ++a)
#pragma unroll
            for (int b = 0; b < 2; ++b)
#pragma unroll
                for (int m = 0; m < 4; ++m)
#pragma unroll
                    for (int n = 0; n < 2; ++n) acc[a][b][m][n] = (f32x4){0.f, 0.f, 0.f, 0.f};
        cur = nxt; cA = nA; cB = nB; ++ui;
        if constexpr (ALIGN_EPI) { if (wr == 1) PG8_BAR; }
    }
    PG8_WAIT_V(0);
    if constexpr (!ALIGN_EPI) { if (wr == 0) PG8_BAR; }
    PG8_BAR;
#undef PG8_SA
#undef PG8_SB
#undef PG8_STAGE
#undef PG8_LDA
#undef PG8_LDB
#undef PG8_MMA
#undef PG8_WAIT_V
#undef PG8_WAIT_L
#undef PG8_BAR
#undef PG8_SCHED
}
}

#define PG8_SP2 true
#define PG8_ALIGN true

constexpr int NWAVES = 8;
constexpr int D = 2048, SEQ = 16384, NBATCH = 2, M_TOK = NBATCH * SEQ, CTXL = 256, M_CTX = NBATCH * CTXL, MT = M_TOK + M_CTX, DEPTH = 4;
constexpr int FF = 8192, EIN = 2560, OIN = 6144, NMODV = 6 * D;
constexpr float NORM_EPS = 1e-6f;
constexpr float ATTN_SCALE = 0.08838834764831845f;

constexpr size_t MiB = 1u << 20;
constexpr size_t WS_CTL = 0, CTL_ZERO_BYTES = 1 * MiB;
constexpr size_t WS_MOD = 1 * MiB;
constexpr size_t WS_ROPE = 2 * MiB;
constexpr size_t WS_W16K = 2 * MiB + 128 * 1024;
constexpr size_t WS_DFT = 3 * MiB;
constexpr size_t DFT_CM = 0, DFT_FB1 = 512 * 256 * 2, DFT_FC2 = DFT_FB1 + 256 * 256 * 2, DFT_F256 = DFT_FC2 + 256 * 256 * 2, DFT_CMH = DFT_F256 + 256 * 512 * 2;
constexpr size_t WS_XC = 4 * MiB;
constexpr size_t WS_WIN_E = 8 * MiB;
constexpr size_t WS_WOUT_E = 28 * MiB;
constexpr size_t WS_WIN_O = 44 * MiB;
constexpr size_t WS_WOUT_O = 92 * MiB;
constexpr size_t WS_W1 = 108 * MiB;
constexpr size_t WS_W2 = 236 * MiB;
constexpr size_t WS_XB = 364 * MiB;
constexpr size_t WS_MO = 494 * MiB;
constexpr size_t WS_BIG = 624 * MiB;
constexpr size_t WS_H = WS_BIG;
constexpr size_t WS_P = WS_BIG;
constexpr size_t WS_Z = WS_BIG + 164 * MiB;
constexpr size_t WS_A1 = WS_BIG + 296 * MiB;
constexpr size_t WS_ZCTX = WS_BIG + 428 * MiB;
constexpr size_t WS_G = WS_BIG;
constexpr size_t WS_ZG = WS_BIG + 130 * MiB;
constexpr size_t WS_AC = WS_BIG + 390 * MiB;
constexpr size_t WS_CSP = WS_BIG + 520 * MiB;
constexpr size_t WS_END = WS_CSP + 64 * MiB;
constexpr int CW_BAR = 4096;

constexpr int RING_OFF = 0, RING_BYTES = 131072;
constexpr int LDSCTL_OFF = RING_BYTES, MISC_OFF = LDSCTL_OFF + 320;
constexpr int LDS_BYTES = 147456;

#define GAS __attribute__((address_space(1)))
#define LAS __attribute__((address_space(3)))
typedef unsigned short bf16;
typedef unsigned v4u __attribute__((ext_vector_type(4)));
typedef unsigned v2u __attribute__((ext_vector_type(2)));
typedef float f32x4 __attribute__((ext_vector_type(4)));
typedef float f32x2 __attribute__((ext_vector_type(2)));
typedef GAS unsigned gu32;
#define RLX_AGENT __ATOMIC_RELAXED, __HIP_MEMORY_SCOPE_AGENT
#define LDS_WAIT() asm volatile("s_waitcnt lgkmcnt(0)" ::: "memory")
#define VM_WAIT() asm volatile("s_waitcnt vmcnt(0)" ::: "memory")
__device__ __forceinline__ unsigned pk2(float lo, float hi) { return pg8::cvt_pk_bf16(lo, hi); }
__device__ __forceinline__ float bflo(unsigned v) { return __uint_as_float(v << 16); }
__device__ __forceinline__ float bfhi(unsigned v) { return __uint_as_float(v & 0xffff0000u); }

#define XB_TMO      128
#define XB_XCNT(j)  (256  + 64 * (j))
#define XB_XSUB(j)  (1280 + 64 * (j))
#define XB_XGEN(j)  (2304 + 64 * (j))
#define XB_TOP      3328
#define XB_TOPGEN   3392
#define XCD_BAR_WORDS 3456
#define XB_SPIN_CAP (1u << 22)
__device__ __forceinline__ unsigned xb_ld(unsigned* p)              { return __hip_atomic_load(p, __ATOMIC_RELAXED, __HIP_MEMORY_SCOPE_AGENT); }
__device__ __forceinline__ unsigned xb_add(unsigned* p, unsigned v) { return __hip_atomic_fetch_add(p, v, __ATOMIC_RELAXED, __HIP_MEMORY_SCOPE_AGENT); }
__device__ __forceinline__ unsigned xb_xcc_id() { return (unsigned)__builtin_amdgcn_s_getreg((3 << 11) | 20) & 0xFu; }
#define XB_SPIN(cond, bar) do { unsigned _sp = 0; while (cond) { __builtin_amdgcn_s_sleep(1); \
    if ((++_sp & 255u) == 0u) { if (xb_ld(&(bar)[XB_TMO])) break; if (_sp > XB_SPIN_CAP) { atomicAdd(&(bar)[XB_TMO], 1u); break; } } } } while (0)
struct XcdBarrier { unsigned* bar; unsigned x; volatile LAS unsigned* st; };
__device__ __forceinline__ XcdBarrier xcd_barrier_post(unsigned* bar, volatile LAS unsigned* st) {
    XcdBarrier b; b.bar = bar; b.x = xb_xcc_id(); b.st = st;
    if (threadIdx.x == 0) (void)xb_add(&bar[XB_XCNT(b.x)], 1u);
    return b;
}
__device__ __forceinline__ void xcd_barrier_complete(unsigned* bar, unsigned x, unsigned& nloc, unsigned& nx) {
    const unsigned G = gridDim.x * gridDim.y * gridDim.z;
    unsigned sum, cnt, mine, sp = 0u;
    for (;;) {
        sum = 0u; cnt = 0u; mine = 0u;
#pragma unroll
        for (unsigned j = 0; j < 16; ++j) { const unsigned c = xb_ld(&bar[XB_XCNT(j)]); sum += c; cnt += (c > 0u) ? 1u : 0u; mine = (j == x) ? c : mine; }
        if (sum == G) break;
        __builtin_amdgcn_s_sleep(1);
        if ((++sp & 255u) == 0u) { if (xb_ld(&bar[XB_TMO])) break; if (sp > XB_SPIN_CAP) { atomicAdd(&bar[XB_TMO], 1u); break; } }
    }
    nloc = mine > 0u ? mine : 1u; nx = cnt > 0u ? cnt : 1u;
}
__device__ __forceinline__ void xcd_barrier_census_early(const XcdBarrier& b) {
    if (threadIdx.x == 0 && b.st) { unsigned nloc = b.st[0], nx = b.st[1]; if (nloc == 0u) { xcd_barrier_complete(b.bar, b.x, nloc, nx); b.st[0] = nloc; b.st[1] = nx; } }
}
__device__ __forceinline__ void xcd_barrier(const XcdBarrier& b) {
    asm volatile("s_waitcnt vmcnt(0)" ::: "memory");
    __syncthreads();
    if (threadIdx.x == 0) {
        unsigned* bar = b.bar;
        __builtin_amdgcn_s_waitcnt(0);
        unsigned nloc = b.st[0], nx = b.st[1];
        if (nloc == 0u) { xcd_barrier_complete(bar, b.x, nloc, nx); b.st[0] = nloc; b.st[1] = nx; }
        const unsigned old = xb_add(&bar[XB_XSUB(b.x)], 1u);
        const unsigned gen = old / nloc;
        if (old + 1u == (gen + 1u) * nloc) {
            __builtin_amdgcn_fence(__ATOMIC_RELEASE, "agent");
            asm volatile("s_waitcnt vmcnt(0)" ::: "memory");
            const unsigned og = xb_add(&bar[XB_TOP], 1u);
            const unsigned tg = og / nx;
            if (og + 1u == (tg + 1u) * nx) xb_add(&bar[XB_TOPGEN], 1u);
            else XB_SPIN(xb_ld(&bar[XB_TOPGEN]) == tg, bar);
            __builtin_amdgcn_fence(__ATOMIC_ACQUIRE, "agent");
            xb_add(&bar[XB_XGEN(b.x)], 1u);
            asm volatile("s_waitcnt vmcnt(0)" ::: "memory");
        } else {
            XB_SPIN(xb_ld(&bar[XB_XGEN(b.x)]) == gen, bar);
            __builtin_amdgcn_fence(__ATOMIC_ACQUIRE, "agent");
            asm volatile("s_waitcnt vmcnt(0)" ::: "memory");
        }
    }
    __syncthreads();
}

struct Frame {
    LAS unsigned char* lds;
    volatile LAS unsigned* MISC;
    gu32* ctl;
    int tid, lane, wave, G, bid;
    const float *x, *c, *ctx, *c_ctx, *w_mod, *b_mod, *gains, *att_w_in, *att_sink, *att_w_out, *conv_w_in, *conv_w, *conv_w_out, *mlp_w1, *mlp_w2;
    float* out; unsigned char* ws;
};

__device__ __forceinline__ float shfl_xor_l(float v, int mask, int lane) { return __int_as_float(__builtin_amdgcn_ds_bpermute((lane ^ mask) << 2, __float_as_int(v))); }
__device__ __forceinline__ float wave_sum_l(float v, int  ) {
#define WS_DPP(ctrl, rmask, bc) __int_as_float(__builtin_amdgcn_update_dpp(0, __float_as_int(v), (ctrl), (rmask), 0xf, (bc)))
    v += WS_DPP(0x111, 0xf, true); v += WS_DPP(0x112, 0xf, true); v += WS_DPP(0x114, 0xf, true); v += WS_DPP(0x118, 0xf, true);
    v += WS_DPP(0x142, 0xa, false);
    v += WS_DPP(0x143, 0xc, false);
#undef WS_DPP
    return __int_as_float(__builtin_amdgcn_readlane(__float_as_int(v), 63));
}
__device__ __forceinline__ float wave_max_l(float v, int lane) {
#pragma unroll
    for (int o = 1; o < 64; o <<= 1) v = fmaxf(v, shfl_xor_l(v, o, lane));
    return v;
}
#define wave_sum(v) wave_sum_l((v), F.lane)
#define wave_max(v) wave_max_l((v), F.lane)

__device__ __forceinline__ void dsincos_small(double r, double& s, double& c) {
    const double r2 = r * r; double ts = 1.0, tc = 1.0, ss = 1.0, cs = 1.0;
#pragma unroll
    for (int n = 1; n <= 11; ++n) { tc *= -r2 * (1.0 / (double)((2 * n - 1) * (2 * n))); cs += tc; ts *= -r2 * (1.0 / (double)((2 * n) * (2 * n + 1))); ss += ts; }
    s = r * ss; c = cs;
}
__device__ __forceinline__ void unit_root(int p, float& co, float& si) {
    const int quad = p >> 12; int rem = p & 4095; bool sw = false;
    if (rem > 2048) { rem = 4096 - rem; sw = true; }
    double s, c; dsincos_small((double)rem * (6.283185307179586476925 / 16384.0), s, c);
    if (sw) { const double t = s; s = c; c = t; }
    double cc = (quad & 1) ? -s : c, sn = (quad & 1) ? c : s;
    if (quad & 2) { cc = -cc; sn = -sn; }
    co = (float)cc; si = (float)sn;
}

__device__ __forceinline__ int four_slot_channel(int k) { const int s_ = k & 255; return k < 1024 ? (k & ~255) + (s_ <= 128 ? s_ : 384 - s_) : k; }
template <bool KPERM = false>
__device__ __forceinline__ void p0_transpose_item(const float* W, int K, int N, bf16* WT, LAS float* scr, int item, int lane) {
    const int nblk = N / 32, kb = item / nblk, nb = item % nblk, k0 = 64 * kb, n0 = 32 * nb;
#pragma unroll 8
    for (int i = 0; i < 32; ++i) { const int kk = 2 * i + (lane >> 5); const int ks = KPERM ? four_slot_channel(k0 + kk) : k0 + kk; scr[kk * 33 + (lane & 31)] = W[(size_t)ks * N + n0 + (lane & 31)]; }
    LDS_WAIT(); asm volatile("" ::: "memory");
    const int c = lane & 7;
#pragma unroll
    for (int j = 0; j < 4; ++j) { const int n = (lane >> 3) + 8 * j; const LAS float* s = scr + (8 * c) * 33 + n;
        v4u o; o.x = pk2(s[0 * 33], s[1 * 33]); o.y = pk2(s[2 * 33], s[3 * 33]); o.z = pk2(s[4 * 33], s[5 * 33]); o.w = pk2(s[6 * 33], s[7 * 33]);
        *(v4u*)(WT + (size_t)(n0 + n) * K + k0 + 8 * c) = o; }
    LDS_WAIT(); asm volatile("" ::: "memory");
}

__device__ __forceinline__ float silu_f(float v) { return v / (1.0f + expf(-v)); }

__device__ __forceinline__ void p0_prologue(Frame& F, const XcdBarrier& bar) {
    const int gt = F.bid * 512 + F.tid, NT = F.G * 512;
    {
        f32x2* rope = (f32x2*)(F.ws + WS_ROPE); f32x2* w16k = (f32x2*)(F.ws + WS_W16K);
        for (int i = gt; i < 16384; i += NT) { float co, si; unit_root(i, co, si); w16k[i] = (f32x2){co, si}; }
        for (int i = gt; i < 256 * 32; i += NT) {
            const int pos = i >> 5, fi = i & 31;
            const double s3 = sqrt(sqrt(sqrt(0.1)));
            double f = 1.0; for (int k = 0; k < fi; ++k) f *= s3;
            const float invf = (float)f; const float af = (float)pos * invf;
            const double a = (double)af; const double kq = rint(a * 0.63661977236758134308);
            const double r = (a - kq * 1.57079632679489655800) - kq * 6.123233995736766036e-17;
            double s, c; dsincos_small(r, s, c); const int q = ((int)kq) & 3; double cc = (q & 1) ? -s : c, sn = (q & 1) ? c : s;
            if (q & 2) { cc = -cc; sn = -sn; }
            rope[i] = (f32x2){(float)cc, (float)sn};
        }
    }
    {
            bf16* cm = (bf16*)(F.ws + WS_DFT + DFT_CM); bf16* fb1 = (bf16*)(F.ws + WS_DFT + DFT_FB1); bf16* fc2 = (bf16*)(F.ws + WS_DFT + DFT_FC2); bf16* f256 = (bf16*)(F.ws + WS_DFT + DFT_F256);
            for (int i = gt; i < 512 * 256; i += NT) { const int row = i >> 8, c = i & 255, ri = row >> 8, j = row & 255; float co, si; unit_root(64 * ((j * c) & 255), co, si); cm[i] = (bf16)(pk2(ri ? -si : co, 0.f) & 0xffffu); }
            for (int i = gt; i < 256 * 256; i += NT) { const int row = i >> 8, col = i & 255, rio = row >> 7, k1 = row & 127, ri = col >> 7, t1 = col & 127; float co, si; unit_root(128 * ((k1 * t1) & 127), co, si);
                const float v = (rio == ri) ? co : (rio ? -si : si); fb1[i] = (bf16)(pk2(v, 0.f) & 0xffffu); }
            for (int i = gt; i < 256 * 256; i += NT) { const int k2 = i >> 8, col = i & 255, ri = col >> 7, t2 = col & 127; float co, si; unit_root(128 * ((k2 * t2) & 127), co, si);
                fc2[i] = (bf16)(pk2(k2 < 128 ? (ri ? si : co) : 0.f, 0.f) & 0xffffu); }
            for (int i = gt; i < 256 * 512; i += NT) { const int k = i >> 9, col = i & 511, ri = col >> 8, t = col & 255; float co, si; unit_root(64 * ((k * t) & 255), co, si); f256[i] = (bf16)(pk2(ri ? si : co, 0.f) & 0xffffu); }
            bf16* cmh = (bf16*)(F.ws + WS_DFT + DFT_CMH);
            for (int i = gt; i < 256 * 256; i += NT) { const int row = i >> 8, c = i & 255, ri = row >> 7, j = row & 127; float co, si; unit_root(64 * (((ri && j == 0 ? 128 : j) * c) & 255), co, si); cmh[i] = (bf16)(pk2((ri && j) ? -si : co, 0.f) & 0xffffu); }
        }
    if (F.bid < 192) {
        LAS float* sv = (LAS float*)(F.lds);
        LAS float* part = (LAS float*)(F.lds + 32768);
        { float cv[3 * D / 512];
#pragma unroll
          for (int q = 0; q < 3 * D / 512; ++q) { const int i = F.tid + 512 * q, r = i / D, k = i % D; cv[q] = r < 2 ? F.c[r * D + k] : F.c_ctx[k]; }
#pragma unroll
          for (int q = 0; q < 3 * D / 512; ++q) sv[F.tid + 512 * q] = silu_f(cv[q]); }
        __syncthreads();
        const int l = F.bid / 48, n0 = (F.bid % 48) * 256;
        const float* W = F.w_mod + (size_t)l * D * NMODV + n0 + 4 * F.lane;
        f32x4 a0 = {0.f, 0.f, 0.f, 0.f}, a1 = a0, a2 = a0;
        const int kbeg = F.wave * 256;
#pragma unroll 16
        for (int k = kbeg; k < kbeg + 256; ++k) { const f32x4 w = *(const f32x4*)(W + (size_t)k * NMODV); a0 += w * sv[k]; a1 += w * sv[D + k]; a2 += w * sv[2 * D + k]; }
        *(LAS f32x4*)(part + (F.wave * 3 + 0) * 256 + 4 * F.lane) = a0;
        *(LAS f32x4*)(part + (F.wave * 3 + 1) * 256 + 4 * F.lane) = a1;
        *(LAS f32x4*)(part + (F.wave * 3 + 2) * 256 + 4 * F.lane) = a2;
        __syncthreads();
        float* MOD = (float*)(F.ws + WS_MOD);
        for (int i = F.tid; i < 768; i += 512) { const int r = i >> 8, n = i & 255; float s = 0.f;
#pragma unroll
            for (int w = 0; w < 8; ++w) s += part[(w * 3 + r) * 256 + n];
            MOD[((size_t)l * 3 + r) * NMODV + n0 + n] = s + F.b_mod[(size_t)l * NMODV + n0 + n]; }
        __syncthreads();
    }
    xcd_barrier_census_early(bar);
    LAS float* scr = (LAS float*)(F.lds + RING_OFF + F.wave * 16384);
    const int gw = F.bid * NWAVES + F.wave, NGW = F.G * NWAVES;
    constexpr int I_WIN_E = (D / 64) * (EIN / 32), I_WO = (D / 64) * (D / 32), I_WIN_O = (D / 64) * (OIN / 32), I_W1 = (D / 64) * (FF / 32), I_W2 = (FF / 64) * (D / 32);
    constexpr int NITEMS = 2 * I_WIN_E + 2 * I_WO + 2 * I_WIN_O + 2 * I_WO + 4 * I_W1 + 4 * I_W2;
    struct TItem { const float* W; bf16* WT; int K, N, perm, item; };
#define T_DECODE(t, it_) { int r = (it_); \
        if (r < 2 * I_WIN_E) { const int a = r / I_WIN_E; t.W = F.att_w_in + (size_t)a * D * EIN; t.WT = (bf16*)(F.ws + WS_WIN_E) + (size_t)a * D * EIN; t.K = D; t.N = EIN; t.perm = 0; t.item = r % I_WIN_E; } \
        else if ((r -= 2 * I_WIN_E) < 2 * I_WO) { const int a = r / I_WO; t.W = F.att_w_out + (size_t)a * D * D; t.WT = (bf16*)(F.ws + WS_WOUT_E) + (size_t)a * D * D; t.K = D; t.N = D; t.perm = 1; t.item = r % I_WO; } \
        else if ((r -= 2 * I_WO) < 2 * I_WIN_O) { const int a = r / I_WIN_O; t.W = F.conv_w_in + (size_t)a * D * OIN; t.WT = (bf16*)(F.ws + WS_WIN_O) + (size_t)a * D * OIN; t.K = D; t.N = OIN; t.perm = 0; t.item = r % I_WIN_O; } \
        else if ((r -= 2 * I_WIN_O) < 2 * I_WO) { const int a = r / I_WO; t.W = F.conv_w_out + (size_t)a * D * D; t.WT = (bf16*)(F.ws + WS_WOUT_O) + (size_t)a * D * D; t.K = D; t.N = D; t.perm = 0; t.item = r % I_WO; } \
        else if ((r -= 2 * I_WO) < 4 * I_W1) { const int a = r / I_W1; t.W = F.mlp_w1 + (size_t)a * D * FF; t.WT = (bf16*)(F.ws + WS_W1) + (size_t)a * D * FF; t.K = D; t.N = FF; t.perm = 0; t.item = r % I_W1; } \
        else { r -= 4 * I_W1; const int a = r / I_W2; t.W = F.mlp_w2 + (size_t)a * D * FF; t.WT = (bf16*)(F.ws + WS_W2) + (size_t)a * D * FF; t.K = FF; t.N = D; t.perm = 0; t.item = r % I_W2; } }
#define T_LOAD(t, v) { const int nblk_ = t.N / 32, k0_ = 64 * (t.item / nblk_), n0_ = 32 * (t.item % nblk_); \
        _Pragma("unroll") for (int i = 0; i < 32; ++i) { const int kk = k0_ + 2 * i + (F.lane >> 5); const int ks = t.perm ? four_slot_channel(kk) : kk; v[i] = t.W[(size_t)ks * t.N + n0_ + (F.lane & 31)]; } }
    if (gw < NITEMS) {
        TItem cur, nxt; float v[32], vn[32];
        T_DECODE(cur, gw) T_LOAD(cur, v)
#pragma unroll 1
        for (int it = gw; it < NITEMS; it += NGW) {
            const bool more = it + NGW < NITEMS;
            if (more) { T_DECODE(nxt, it + NGW) T_LOAD(nxt, vn) }
            const int nblk = cur.N / 32, k0 = 64 * (cur.item / nblk), n0 = 32 * (cur.item % nblk);
#pragma unroll
            for (int i = 0; i < 32; ++i) scr[(2 * i + (F.lane >> 5)) * 33 + (F.lane & 31)] = v[i];
            LDS_WAIT(); asm volatile("" ::: "memory");
            const int c = F.lane & 7;
#pragma unroll
            for (int jj = 0; jj < 4; ++jj) { const int n = (F.lane >> 3) + 8 * jj; const LAS float* sp = scr + (8 * c) * 33 + n;
                v4u o; o.x = pk2(sp[0 * 33], sp[1 * 33]); o.y = pk2(sp[2 * 33], sp[3 * 33]); o.z = pk2(sp[4 * 33], sp[5 * 33]); o.w = pk2(sp[6 * 33], sp[7 * 33]);
                *(v4u*)(cur.WT + (size_t)(n0 + n) * cur.K + k0 + 8 * c) = o; }
            LDS_WAIT(); asm volatile("" ::: "memory");
            if (more) { cur = nxt;
#pragma unroll
                for (int i = 0; i < 32; ++i) v[i] = vn[i]; }
        }
    }
#undef T_DECODE
#undef T_LOAD
}

template <int NR, bool CTX, bool HAS_MO, bool HAS_UX, bool XIN16, bool XOUT16>
__device__ __forceinline__ void r_rows(Frame& F, const float* xin0, const float* xin1, float* xout0, float* xout1, const bf16* mo0, const bf16* mo1, bf16* ux0, bf16* ux1,
                                       const float* sl, int nsplit, const LAS float* pr) {
    f32x4 xv0[8], xv1[8], mv0[8], mv1[8];
#pragma unroll
    for (int j = 0; j < 8; ++j) {
        if (XIN16) { const v2u w = __builtin_nontemporal_load((const v2u*)((const bf16*)xin0 + 256 * j)); xv0[j] = (f32x4){bflo(w.x), bfhi(w.x), bflo(w.y), bfhi(w.y)};
            if (NR == 2) { const v2u w1 = __builtin_nontemporal_load((const v2u*)((const bf16*)xin1 + 256 * j)); xv1[j] = (f32x4){bflo(w1.x), bfhi(w1.x), bflo(w1.y), bfhi(w1.y)}; } }
        else { xv0[j] = __builtin_nontemporal_load((const f32x4*)(xin0 + 256 * j)); if (NR == 2) xv1[j] = __builtin_nontemporal_load((const f32x4*)(xin1 + 256 * j)); } }
    if (HAS_MO) {
        if (CTX && nsplit > 0) {
#pragma unroll
            for (int j = 0; j < 8; ++j) mv0[j] = *(const f32x4*)(sl + 256 * j);
#pragma unroll 1
            for (int sp = 1; sp < nsplit; ++sp) { sl += (size_t)M_CTX * D; f32x4 t[8];
#pragma unroll
                for (int j = 0; j < 8; ++j) t[j] = *(const f32x4*)(sl + 256 * j);
#pragma unroll
                for (int j = 0; j < 8; ++j) mv0[j] += t[j]; }
        } else {
#pragma unroll
            for (int j = 0; j < 8; ++j) { const v2u w = __builtin_nontemporal_load((const v2u*)(mo0 + 256 * j)); mv0[j] = (f32x4){bflo(w.x), bfhi(w.x), bflo(w.y), bfhi(w.y)}; } }
        if (NR == 2) {
#pragma unroll
            for (int j = 0; j < 8; ++j) { const v2u w = __builtin_nontemporal_load((const v2u*)(mo1 + 256 * j)); mv1[j] = (f32x4){bflo(w.x), bfhi(w.x), bflo(w.y), bfhi(w.y)}; } }
        float s0 = 0.f, s1 = 0.f;
#pragma unroll
        for (int j = 0; j < 8; ++j) { s0 += (mv0[j].x * mv0[j].x + mv0[j].y * mv0[j].y) + (mv0[j].z * mv0[j].z + mv0[j].w * mv0[j].w);
            if (NR == 2) s1 += (mv1[j].x * mv1[j].x + mv1[j].y * mv1[j].y) + (mv1[j].z * mv1[j].z + mv1[j].w * mv1[j].w); }
        const float rstd0 = 1.0f / sqrtf(wave_sum(s0) * (1.0f / D) + NORM_EPS), rstd1 = NR == 2 ? 1.0f / sqrtf(wave_sum(s1) * (1.0f / D) + NORM_EPS) : 0.f;
#pragma unroll
        for (int j = 0; j < 8; ++j) { const f32x4 a1 = *(const LAS f32x4*)(pr + 256 * j);
            xv0[j] = xv0[j] + a1 * (mv0[j] * rstd0); if (NR == 2) xv1[j] = xv1[j] + a1 * (mv1[j] * rstd1); }
#pragma unroll
        for (int j = 0; j < 8; ++j) {
            if (XOUT16) { v2u w; w.x = pk2(xv0[j].x, xv0[j].y); w.y = pk2(xv0[j].z, xv0[j].w); __builtin_nontemporal_store(w, (v2u*)((bf16*)xout0 + 256 * j));
                if (NR == 2) { v2u w1; w1.x = pk2(xv1[j].x, xv1[j].y); w1.y = pk2(xv1[j].z, xv1[j].w); __builtin_nontemporal_store(w1, (v2u*)((bf16*)xout1 + 256 * j)); } }
            else { __builtin_nontemporal_store(xv0[j], (f32x4*)(xout0 + 256 * j)); if (NR == 2) __builtin_nontemporal_store(xv1[j], (f32x4*)(xout1 + 256 * j)); } }
    }
    if (HAS_UX) {
        float s0 = 0.f, s1 = 0.f;
#pragma unroll
        for (int j = 0; j < 8; ++j) { s0 += (xv0[j].x * xv0[j].x + xv0[j].y * xv0[j].y) + (xv0[j].z * xv0[j].z + xv0[j].w * xv0[j].w);
            if (NR == 2) s1 += (xv1[j].x * xv1[j].x + xv1[j].y * xv1[j].y) + (xv1[j].z * xv1[j].z + xv1[j].w * xv1[j].w); }
        const float rstd0 = 1.0f / sqrtf(wave_sum(s0) * (1.0f / D) + NORM_EPS), rstd1 = NR == 2 ? 1.0f / sqrtf(wave_sum(s1) * (1.0f / D) + NORM_EPS) : 0.f;
#pragma unroll
        for (int j = 0; j < 8; ++j) { const f32x4 a2 = *(const LAS f32x4*)(pr + D + 256 * j), a3 = *(const LAS f32x4*)(pr + 2 * D + 256 * j);
            { const f32x4 u = (xv0[j] * rstd0) * a2 + a3; v2u w; w.x = pk2(u.x, u.y); w.y = pk2(u.z, u.w); *(v2u*)(ux0 + 256 * j) = w; }
            if (NR == 2) { const f32x4 u = (xv1[j] * rstd1) * a2 + a3; v2u w; w.x = pk2(u.x, u.y); w.y = pk2(u.z, u.w); *(v2u*)(ux1 + 256 * j) = w; } }
    }
}

#define BF4(w) ((f32x4){bflo((w).x), bfhi((w).x), bflo((w).y), bfhi((w).y)})
template <bool HAS_MO, bool HAS_UX, bool XIN16, bool XOUT16>
__device__ __forceinline__ void r_pairs(Frame& F, const float* xsrc, float* xdst, const bf16* MO, bf16* UX, const LAS float* par, int gw, int NGW) {
    const int l4 = 4 * F.lane; const size_t pairstep = (size_t)NGW * D;
    f32x4 rxf0[8], rxf1[8]; v2u rxh0[8], rxh1[8], rm0[8], rm1[8];
#define R_LOAD(m_) { const size_t o0_ = (size_t)(m_) * D + l4, o1_ = o0_ + pairstep; \
        _Pragma("unroll") for (int j = 0; j < 8; ++j) { \
            if (XIN16) { rxh0[j] = __builtin_nontemporal_load((const v2u*)((const bf16*)xsrc + o0_ + 256 * j)); rxh1[j] = __builtin_nontemporal_load((const v2u*)((const bf16*)xsrc + o1_ + 256 * j)); } \
            else { rxf0[j] = __builtin_nontemporal_load((const f32x4*)(xsrc + o0_ + 256 * j)); rxf1[j] = __builtin_nontemporal_load((const f32x4*)(xsrc + o1_ + 256 * j)); } } \
        if (HAS_MO) { _Pragma("unroll") for (int j = 0; j < 8; ++j) { rm0[j] = __builtin_nontemporal_load((const v2u*)(MO + o0_ + 256 * j)); rm1[j] = __builtin_nontemporal_load((const v2u*)(MO + o1_ + 256 * j)); } } }
    int m0 = gw;
    if (m0 < M_TOK) R_LOAD(m0);
#pragma unroll 1
    while (m0 < M_TOK) {
        f32x4 xv0[8], xv1[8]; v2u cm0[8], cm1[8];
#pragma unroll
        for (int j = 0; j < 8; ++j) { xv0[j] = XIN16 ? BF4(rxh0[j]) : rxf0[j]; xv1[j] = XIN16 ? BF4(rxh1[j]) : rxf1[j]; if (HAS_MO) { cm0[j] = rm0[j]; cm1[j] = rm1[j]; } }
        const int mn = m0 + 2 * NGW;
        if (mn < M_TOK) R_LOAD(mn);
        const size_t o0 = (size_t)m0 * D + l4, o1 = o0 + pairstep;
        const LAS float* pr = par + (size_t)(m0 / SEQ) * 3 * D + l4;
        if (HAS_MO) {
            float s0 = 0.f, s1 = 0.f;
#pragma unroll
            for (int j = 0; j < 8; ++j) { const f32x4 a = BF4(cm0[j]), b = BF4(cm1[j]);
                s0 += (a.x * a.x + a.y * a.y) + (a.z * a.z + a.w * a.w); s1 += (b.x * b.x + b.y * b.y) + (b.z * b.z + b.w * b.w); }
            const float rstd0 = 1.0f / sqrtf(wave_sum(s0) * (1.0f / D) + NORM_EPS), rstd1 = 1.0f / sqrtf(wave_sum(s1) * (1.0f / D) + NORM_EPS);
#pragma unroll
            for (int j = 0; j < 8; ++j) { const f32x4 a1 = *(const LAS f32x4*)(pr + 256 * j);
                xv0[j] = xv0[j] + a1 * (BF4(cm0[j]) * rstd0); xv1[j] = xv1[j] + a1 * (BF4(cm1[j]) * rstd1); }
#pragma unroll
            for (int j = 0; j < 8; ++j) {
                if (XOUT16) { v2u w; w.x = pk2(xv0[j].x, xv0[j].y); w.y = pk2(xv0[j].z, xv0[j].w); __builtin_nontemporal_store(w, (v2u*)((bf16*)xdst + o0 + 256 * j));
                    v2u w1; w1.x = pk2(xv1[j].x, xv1[j].y); w1.y = pk2(xv1[j].z, xv1[j].w); __builtin_nontemporal_store(w1, (v2u*)((bf16*)xdst + o1 + 256 * j)); }
                else { __builtin_nontemporal_store(xv0[j], (f32x4*)(xdst + o0 + 256 * j)); __builtin_nontemporal_store(xv1[j], (f32x4*)(xdst + o1 + 256 * j)); } }
        }
        if (HAS_UX) {
            float s0 = 0.f, s1 = 0.f;
#pragma unroll
            for (int j = 0; j < 8; ++j) { s0 += (xv0[j].x * xv0[j].x + xv0[j].y * xv0[j].y) + (xv0[j].z * xv0[j].z + xv0[j].w * xv0[j].w);
                s1 += (xv1[j].x * xv1[j].x + xv1[j].y * xv1[j].y) + (xv1[j].z * xv1[j].z + xv1[j].w * xv1[j].w); }
            const float rstd0 = 1.0f / sqrtf(wave_sum(s0) * (1.0f / D) + NORM_EPS), rstd1 = 1.0f / sqrtf(wave_sum(s1) * (1.0f / D) + NORM_EPS);
#pragma unroll
            for (int j = 0; j < 8; ++j) { const f32x4 a2 = *(const LAS f32x4*)(pr + D + 256 * j), a3 = *(const LAS f32x4*)(pr + 2 * D + 256 * j);
                { const f32x4 u = (xv0[j] * rstd0) * a2 + a3; v2u w; w.x = pk2(u.x, u.y); w.y = pk2(u.z, u.w); *(v2u*)(UX + o0 + 256 * j) = w; }
                { const f32x4 u = (xv1[j] * rstd1) * a2 + a3; v2u w; w.x = pk2(u.x, u.y); w.y = pk2(u.z, u.w); *(v2u*)(UX + o1 + 256 * j) = w; } }
        }
        m0 = mn;
    }
#undef R_LOAD
}

template <bool HAS_MO, bool HAS_UX, bool FIRST>
__device__ __forceinline__ void r_phase_t(Frame& F, int nrows, int nsplit,
                                          const float* modg, int gate_ci, const float* gnorm,
                                          const float* modn, int sh_ci, int sc_ci, const float* gmod) {
    const int gw = F.bid * NWAVES + F.wave, NGW = F.G * NWAVES;
    const bf16* MO = (const bf16*)(F.ws + WS_MO); bf16* UX = RESID_BF16 ? (bf16*)F.out : (bf16*)(F.ws + WS_XB); float* XC = (float*)(F.ws + WS_XC);
    LAS float* par = (LAS float*)F.lds;
    {
    static_assert(D % (NWAVES * 64) == 0, "parameter fill assumes whole strides");
    constexpr int PK = D / (NWAVES * 64);
    float pg[3][PK], pn[PK], pm[PK], psc[3][PK], psh[3][PK];
#pragma unroll
    for (int k = 0; k < PK; ++k) { const int c = F.tid + k * NWAVES * 64;
        if (HAS_MO) pn[k] = gnorm[c];
        if (HAS_UX) pm[k] = gmod[c];
#pragma unroll
        for (int r = 0; r < 3; ++r) {
            if (HAS_MO) pg[r][k] = modg[(size_t)r * NMODV + gate_ci * D + c];
            if (HAS_UX) { psc[r][k] = modn[(size_t)r * NMODV + sc_ci * D + c]; psh[r][k] = modn[(size_t)r * NMODV + sh_ci * D + c]; } } }
#pragma unroll
    for (int k = 0; k < PK; ++k) { const int c = F.tid + k * NWAVES * 64;
#pragma unroll
        for (int r = 0; r < 3; ++r) {
            if (HAS_MO) par[(r * 3 + 0) * D + c] = pg[r][k] * pn[k];
            if (HAS_UX) { par[(r * 3 + 1) * D + c] = pm[k] * (1.0f + psc[r][k]); par[(r * 3 + 2) * D + c] = psh[r][k]; } } }
    }
    __syncthreads();
    const int l4 = 4 * F.lane; constexpr bool first = FIRST;
    bf16* XB = (bf16*)(F.ws + WS_XB);
    constexpr bool XIN16 = RESID_BF16 && !FIRST, XOUT16 = RESID_BF16 && HAS_UX; constexpr int SI = XIN16 ? 2 : 1, SO = XOUT16 ? 2 : 1;
    const float* xsrc = FIRST ? F.x : (XIN16 ? (const float*)XB : F.out); float* xdst = XOUT16 ? (float*)XB : F.out;
    for (int c = F.bid + F.G * F.wave; c < nrows - M_TOK; c += NGW) {
        const float* xin = (first ? F.ctx : XC) + (size_t)c * D + l4;
        r_rows<1, true, HAS_MO, HAS_UX, false, false>(F, xin, xin, XC + (size_t)c * D + l4, nullptr, MO + (size_t)(M_TOK + c) * D + l4, nullptr, UX + (size_t)(M_TOK + c) * D + l4, nullptr,
                                        (const float*)(F.ws + WS_CSP) + (size_t)c * D + l4, nsplit, par + (size_t)2 * 3 * D + l4);
    }
    if (SEQ % (2 * NGW) == 0) {
        r_pairs<HAS_MO, HAS_UX, XIN16, XOUT16>(F, xsrc, xdst, MO, UX, par, gw, NGW);
    } else {
        for (int m0 = gw; m0 < M_TOK; m0 += NGW)
            r_rows<1, false, HAS_MO, HAS_UX, XIN16, XOUT16>(F, xsrc + ((size_t)m0 * D + l4) / SI, nullptr, xdst + ((size_t)m0 * D + l4) / SO, nullptr, MO + (size_t)m0 * D + l4, nullptr, UX + (size_t)m0 * D + l4, nullptr, nullptr, 0, par + (size_t)(m0 / SEQ) * 3 * D + l4);
    }
    __syncthreads();
}
__device__ __forceinline__ void r_phase(Frame& F, int nrows, bool first, bool has_mo, bool has_ux, int nsplit,
                                        const float* modg, int gate_ci, const float* gnorm,
                                        const float* modn, int sh_ci, int sc_ci, const float* gmod) {
    if (!has_mo) r_phase_t<false, true, true>(F, nrows, nsplit, modg, gate_ci, gnorm, modn, sh_ci, sc_ci, gmod);
    else if (first) r_phase_t<true, true, true>(F, nrows, nsplit, modg, gate_ci, gnorm, modn, sh_ci, sc_ci, gmod);
    else if (has_ux) r_phase_t<true, true, false>(F, nrows, nsplit, modg, gate_ci, gnorm, modn, sh_ci, sc_ci, gmod);
    else r_phase_t<true, false, false>(F, nrows, nsplit, modg, gate_ci, gnorm, modn, sh_ci, sc_ci, gmod);
}

typedef float f32x16 __attribute__((ext_vector_type(16)));
typedef short v4i16_t __attribute__((ext_vector_type(4)));
typedef short bf16x8_t __attribute__((ext_vector_type(8)));
constexpr int AT_ROWB = 272, AT_TILEB = 64 * AT_ROWB, AT_BUFB = 2 * AT_TILEB;
__device__ __forceinline__ void attn_mfma(Frame& F, const float* sink, bool with_ctx_q) {
    const bf16* P = (const bf16*)(F.ws + WS_P); bf16* MIX = (bf16*)(F.ws + WS_Z);
    const int lane = F.lane, r = lane & 31, hlf = lane >> 5, hh = F.wave & 1, qs = F.wave >> 1;
    const int nunits = 1024 + (with_ctx_q ? 16 : 0);
    constexpr float LOG2E = 1.4426950408889634f, SC2 = ATTN_SCALE * LOG2E;
    const int c0row = F.tid >> 4, c0ch = F.tid & 15;
    const unsigned st_off0 = (unsigned)(c0row * AT_ROWB + c0ch * 16), st_off1 = st_off0 + 32u * AT_ROWB;
    const int tq = (lane & 15) >> 2, tp = lane & 3, tblk = (lane >> 4) & 1;
    const unsigned vrd = (unsigned)((4 * hlf + tq) * AT_ROWB + (2 * tblk + (tp >> 1)) * 16 + 8 * (tp & 1));
    const unsigned krd = (unsigned)(r * AT_ROWB + 16 * hlf);
    for (int u = F.bid; u < nunits; u += F.G) {
        int b, nb, kvh, gp; const bool cq = u >= 1024;
        if (!cq) { gp = u & 1; kvh = (u >> 1) & 1; nb = (u >> 2) & 127; b = u >> 9; } else { const int v = u - 1024; gp = v & 1; kvh = (v >> 1) & 1; nb = (v >> 2) & 1; b = v >> 3; }
        const int h = kvh * 4 + gp * 2 + hh;
        const size_t qrow = cq ? (size_t)M_TOK + b * CTXL + nb * 128 + qs * 32 + r : (size_t)b * SEQ + nb * 128 + qs * 32 + r;
        bf16x8_t qf[8];
#pragma unroll
        for (int ks = 0; ks < 8; ++ks) qf[ks] = *(const bf16x8_t*)(P + qrow * EIN + 1024 + h * 128 + 16 * ks + 8 * hlf);
        int jlo = 0, jhi = 6; if (cq) { jhi = 0; } else { if (nb == 0) jlo = 2; if (nb == 127) jhi = 4; }
        const int nloc = jhi - jlo, nt = nloc + 4;
        const size_t locrow0 = (size_t)b * SEQ + (size_t)(nb - 1) * 128, ctxrow0 = (size_t)M_TOK + (size_t)b * CTXL;
        const size_t kcol = 2048 + kvh * 128, vcol = 2304 + kvh * 128;
#define AT_TROW(t) ((t) < nloc ? locrow0 + 64 * (size_t)(jlo + (t)) : ctxrow0 + 64 * (size_t)((t) - nloc))
        v4u kst0, kst1, vst0, vst1;
        { const size_t tr0 = AT_TROW(0); const bf16* g0 = P + (tr0 + c0row) * EIN + c0ch * 8; const bf16* g1 = g0 + (size_t)32 * EIN;
          kst0 = *(const v4u*)(g0 + kcol); kst1 = *(const v4u*)(g1 + kcol); vst0 = *(const v4u*)(g0 + vcol); vst1 = *(const v4u*)(g1 + vcol);
          *(LAS v4u*)(F.lds + st_off0) = kst0; *(LAS v4u*)(F.lds + st_off1) = kst1; *(LAS v4u*)(F.lds + AT_TILEB + st_off0) = vst0; *(LAS v4u*)(F.lds + AT_TILEB + st_off1) = vst1; }
        if (nt > 1) { const size_t tr1 = AT_TROW(1); const bf16* g0 = P + (tr1 + c0row) * EIN + c0ch * 8; const bf16* g1 = g0 + (size_t)32 * EIN;
            kst0 = *(const v4u*)(g0 + kcol); kst1 = *(const v4u*)(g1 + kcol); vst0 = *(const v4u*)(g0 + vcol); vst1 = *(const v4u*)(g1 + vcol); }
        __syncthreads();
        f32x16 o0, o1, o2, o3;
#pragma unroll
        for (int i = 0; i < 16; ++i) { o0[i] = 0.f; o1[i] = 0.f; o2[i] = 0.f; o3[i] = 0.f; }
        float m = sink[h] * LOG2E, l = 1.0f;
        const int qi = qs * 32 + r;
        for (int t = 0; t < nt; ++t) {
            v4u kn0, kn1, vn0, vn1;
            if (t + 2 < nt) { const size_t tr2 = AT_TROW(t + 2); const bf16* g0 = P + (tr2 + c0row) * EIN + c0ch * 8; const bf16* g1 = g0 + (size_t)32 * EIN;
                kn0 = *(const v4u*)(g0 + kcol); kn1 = *(const v4u*)(g1 + kcol); vn0 = *(const v4u*)(g0 + vcol); vn1 = *(const v4u*)(g1 + vcol); }
            const LAS unsigned char* kbuf = F.lds + (t & 1) * AT_BUFB; const LAS unsigned char* vbuf = kbuf + AT_TILEB;
            const bool dead = !cq && t < nloc && ((jlo + t == 0 && qs >= 2) || (jlo + t == 5 && qs <= 1));
            if (!dead) {
            f32x16 s0, s1;
#pragma unroll
            for (int i = 0; i < 16; ++i) { s0[i] = 0.f; s1[i] = 0.f; }
#pragma unroll
            for (int ks = 0; ks < 8; ++ks) { const bf16x8_t a0 = *(const LAS bf16x8_t*)(kbuf + krd + ks * 32), a1 = *(const LAS bf16x8_t*)(kbuf + krd + 32 * AT_ROWB + ks * 32);
                s0 = __builtin_amdgcn_mfma_f32_32x32x16_bf16(a0, qf[ks], s0, 0, 0, 0); s1 = __builtin_amdgcn_mfma_f32_32x32x16_bf16(a1, qf[ks], s1, 0, 0, 0); }
            int mtype = 0, kk0 = 0;
            if (!cq && t < nloc) { const int j = jlo + t; if (j < 2) { mtype = 1; kk0 = 64 * j; } else if (j >= 4) { mtype = 2; kk0 = 64 * (j - 4); } }
            float rmx = -1e30f;
#pragma unroll
            for (int i = 0; i < 16; ++i) { const int key = (i & 3) + 8 * (i >> 2) + 4 * hlf; float a = s0[i], c = s1[i];
                if (mtype == 1) { if (kk0 + key < qi) a = -1e30f; if (kk0 + 32 + key < qi) c = -1e30f; }
                if (mtype == 2) { if (kk0 + key > qi) a = -1e30f; if (kk0 + 32 + key > qi) c = -1e30f; }
                s0[i] = a; s1[i] = c; rmx = fmaxf(rmx, fmaxf(a, c)); }
            rmx = fmaxf(rmx, shfl_xor_l(rmx, 32, lane));
            const float cand = rmx * SC2;
            if (__builtin_amdgcn_ballot_w64(cand > m + 8.0f) != 0) {
                const float mn = fmaxf(m, cand); const float alpha = __builtin_amdgcn_exp2f(m - mn); m = mn; l *= alpha;
#pragma unroll
                for (int i = 0; i < 16; ++i) { o0[i] *= alpha; o1[i] *= alpha; o2[i] *= alpha; o3[i] *= alpha; } }
            float rs = 0.f;
#pragma unroll
            for (int i = 0; i < 16; ++i) { const float a = __builtin_amdgcn_exp2f(__builtin_fmaf(s0[i], SC2, -m)), c = __builtin_amdgcn_exp2f(__builtin_fmaf(s1[i], SC2, -m)); s0[i] = a; s1[i] = c; rs += a + c; }
            rs += shfl_xor_l(rs, 32, lane);
            l += rs;
            bf16x8_t pf00, pf01, pf10, pf11;
            { v4u w; w.x = pk2(s0[0], s0[1]); w.y = pk2(s0[2], s0[3]); w.z = pk2(s0[4], s0[5]); w.w = pk2(s0[6], s0[7]); pf00 = __builtin_bit_cast(bf16x8_t, w);
              w.x = pk2(s0[8], s0[9]); w.y = pk2(s0[10], s0[11]); w.z = pk2(s0[12], s0[13]); w.w = pk2(s0[14], s0[15]); pf01 = __builtin_bit_cast(bf16x8_t, w);
              w.x = pk2(s1[0], s1[1]); w.y = pk2(s1[2], s1[3]); w.z = pk2(s1[4], s1[5]); w.w = pk2(s1[6], s1[7]); pf10 = __builtin_bit_cast(bf16x8_t, w);
              w.x = pk2(s1[8], s1[9]); w.y = pk2(s1[10], s1[11]); w.z = pk2(s1[12], s1[13]); w.w = pk2(s1[14], s1[15]); pf11 = __builtin_bit_cast(bf16x8_t, w); }
#define AT_VFRAG(dst, db, kbs) do { const v4i16_t lo_ = __builtin_amdgcn_ds_read_tr16_b64_v4i16((LAS v4i16_t*)(vbuf + vrd + (kbs) * 16 * AT_ROWB + (db) * 64)); \
                const v4i16_t hi_ = __builtin_amdgcn_ds_read_tr16_b64_v4i16((LAS v4i16_t*)(vbuf + vrd + ((kbs) * 16 + 8) * AT_ROWB + (db) * 64)); \
                dst = (bf16x8_t){lo_[0], lo_[1], lo_[2], lo_[3], hi_[0], hi_[1], hi_[2], hi_[3]}; } while (0)
#define AT_PV(oacc, db) do { bf16x8_t vf_; AT_VFRAG(vf_, db, 0); oacc = __builtin_amdgcn_mfma_f32_32x32x16_bf16(vf_, pf00, oacc, 0, 0, 0); AT_VFRAG(vf_, db, 1); oacc = __builtin_amdgcn_mfma_f32_32x32x16_bf16(vf_, pf01, oacc, 0, 0, 0); \
                AT_VFRAG(vf_, db, 2); oacc = __builtin_amdgcn_mfma_f32_32x32x16_bf16(vf_, pf10, oacc, 0, 0, 0); AT_VFRAG(vf_, db, 3); oacc = __builtin_amdgcn_mfma_f32_32x32x16_bf16(vf_, pf11, oacc, 0, 0, 0); } while (0)
            AT_PV(o0, 0); AT_PV(o1, 1); AT_PV(o2, 2); AT_PV(o3, 3);
            }
            if (t + 1 < nt) { LAS unsigned char* nb_ = F.lds + ((t + 1) & 1) * AT_BUFB;
                *(LAS v4u*)(nb_ + st_off0) = kst0; *(LAS v4u*)(nb_ + st_off1) = kst1; *(LAS v4u*)(nb_ + AT_TILEB + st_off0) = vst0; *(LAS v4u*)(nb_ + AT_TILEB + st_off1) = vst1; }
            __syncthreads();
            if (t + 2 < nt) { kst0 = kn0; kst1 = kn1; vst0 = vn0; vst1 = vn1; }
        }
        const float inv = 1.0f / l;
        bf16* orow = MIX + qrow * D + 1024 + h * 128 + 4 * hlf;
#pragma unroll
        for (int g4 = 0; g4 < 4; ++g4) { v2u w;
            w.x = pk2(o0[4 * g4] * inv, o0[4 * g4 + 1] * inv); w.y = pk2(o0[4 * g4 + 2] * inv, o0[4 * g4 + 3] * inv); *(v2u*)(orow + 0 + 8 * g4) = w;
            w.x = pk2(o1[4 * g4] * inv, o1[4 * g4 + 1] * inv); w.y = pk2(o1[4 * g4 + 2] * inv, o1[4 * g4 + 3] * inv); *(v2u*)(orow + 32 + 8 * g4) = w;
            w.x = pk2(o2[4 * g4] * inv, o2[4 * g4 + 1] * inv); w.y = pk2(o2[4 * g4 + 2] * inv, o2[4 * g4 + 3] * inv); *(v2u*)(orow + 64 + 8 * g4) = w;
            w.x = pk2(o3[4 * g4] * inv, o3[4 * g4 + 1] * inv); w.y = pk2(o3[4 * g4 + 2] * inv, o3[4 * g4 + 3] * inv); *(v2u*)(orow + 96 + 8 * g4) = w; }
#undef AT_TROW
#undef AT_VFRAG
#undef AT_PV
    }
}

__device__ __forceinline__ void attn_mfma2(Frame& F, const float* sink, bool with_ctx_q) {
    const bf16* P = (const bf16*)(F.ws + WS_P); bf16* MIX = (bf16*)(F.ws + WS_Z);
    const int lane = F.lane, r = lane & 31, hlf = lane >> 5, hh = F.wave & 1, qs = F.wave >> 1;
    const int nunits = 1024 + (with_ctx_q ? 16 : 0);
    constexpr float LOG2E = 1.4426950408889634f, SC2 = ATTN_SCALE * LOG2E;
    const int c0row = F.tid >> 4, c0ch = F.tid & 15;
    const unsigned st_off0 = (unsigned)(c0row * AT_ROWB + c0ch * 16), st_off1 = st_off0 + 32u * AT_ROWB;
    const int tq = (lane & 15) >> 2, tp = lane & 3, tblk = (lane >> 4) & 1;
    const unsigned vrd = (unsigned)((4 * hlf + tq) * AT_ROWB + (2 * tblk + (tp >> 1)) * 16 + 8 * (tp & 1));
    const unsigned krd = (unsigned)(r * AT_ROWB + 16 * hlf);
    for (int u = F.bid; u < nunits; u += F.G) {
        int b, nb, kvh, gp; const bool cq = u >= 1024;
        if (!cq) { gp = u & 1; kvh = (u >> 1) & 1; nb = (u >> 2) & 127; b = u >> 9; } else { const int v = u - 1024; gp = v & 1; kvh = (v >> 1) & 1; nb = (v >> 2) & 1; b = v >> 3; }
        const int h = kvh * 4 + gp * 2 + hh;
        const size_t qrow = cq ? (size_t)M_TOK + b * CTXL + nb * 128 + qs * 32 + r : (size_t)b * SEQ + nb * 128 + qs * 32 + r;
        bf16x8_t qf[8];
#pragma unroll
        for (int ks = 0; ks < 8; ++ks) qf[ks] = *(const bf16x8_t*)(P + qrow * EIN + 1024 + h * 128 + 16 * ks + 8 * hlf);
        int jlo = 0, jhi = 6; if (cq) { jhi = 0; } else { if (nb == 0) jlo = 2; if (nb == 127) jhi = 4; }
        const int nloc = jhi - jlo, nt = nloc + 4;
        const size_t locrow0 = (size_t)b * SEQ + (size_t)(nb - 1) * 128, ctxrow0 = (size_t)M_TOK + (size_t)b * CTXL;
        const size_t kcol = 2048 + kvh * 128, vcol = 2304 + kvh * 128;
        const int qi = qs * 32 + r;
#define AT_TROW(t) ((t) < nloc ? locrow0 + 64 * (size_t)(jlo + (t)) : ctxrow0 + 64 * (size_t)((t) - nloc))
#define AT_GP(t) (P + (AT_TROW(t) + c0row) * EIN + c0ch * 8)
#define AT_SCORE(d0, d1, kb_) do { _Pragma("unroll") for (int i = 0; i < 16; ++i) { d0[i] = 0.f; d1[i] = 0.f; } \
            _Pragma("unroll") for (int ks = 0; ks < 8; ++ks) { const bf16x8_t a0 = *(const LAS bf16x8_t*)((kb_) + krd + ks * 32), a1 = *(const LAS bf16x8_t*)((kb_) + krd + 32 * AT_ROWB + ks * 32); \
                d0 = __builtin_amdgcn_mfma_f32_32x32x16_bf16(a0, qf[ks], d0, 0, 0, 0); d1 = __builtin_amdgcn_mfma_f32_32x32x16_bf16(a1, qf[ks], d1, 0, 0, 0); } } while (0)
#define AT_MASK(d0, d1, tt) do { int mtype = 0, kk0 = 0; \
            if (!cq && (tt) < nloc) { const int j = jlo + (tt); if (j < 2) { mtype = 1; kk0 = 64 * j; } else if (j >= 4) { mtype = 2; kk0 = 64 * (j - 4); } } \
            int qd = qi - kk0 - 4 * hlf; asm volatile("" : "+v"(qd));     \
            if (mtype == 1) { _Pragma("unroll") for (int i = 0; i < 16; ++i) { const int key = (i & 3) + 8 * (i >> 2); if (key < qd) d0[i] = -1e30f; if (32 + key < qd) d1[i] = -1e30f; } } \
            if (mtype == 2) { _Pragma("unroll") for (int i = 0; i < 16; ++i) { const int key = (i & 3) + 8 * (i >> 2); if (key > qd) d0[i] = -1e30f; if (32 + key > qd) d1[i] = -1e30f; } } } while (0)
        v4u ka0, ka1, va0, va1;
        {   const bf16* g0 = AT_GP(0); const bf16* g1 = AT_GP(1);
            const v4u k00 = *(const v4u*)(g0 + kcol), k01 = *(const v4u*)(g0 + (size_t)32 * EIN + kcol), v00 = *(const v4u*)(g0 + vcol), v01 = *(const v4u*)(g0 + (size_t)32 * EIN + vcol);
            const v4u k10 = *(const v4u*)(g1 + kcol), k11 = *(const v4u*)(g1 + (size_t)32 * EIN + kcol);
            *(LAS v4u*)(F.lds + st_off0) = k00; *(LAS v4u*)(F.lds + st_off1) = k01; *(LAS v4u*)(F.lds + AT_TILEB + st_off0) = v00; *(LAS v4u*)(F.lds + AT_TILEB + st_off1) = v01;
            *(LAS v4u*)(F.lds + AT_BUFB + st_off0) = k10; *(LAS v4u*)(F.lds + AT_BUFB + st_off1) = k11; }
        __syncthreads();
        f32x16 o0, o1, o2, o3;
#pragma unroll
        for (int i = 0; i < 16; ++i) { o0[i] = 0.f; o1[i] = 0.f; o2[i] = 0.f; o3[i] = 0.f; }
        float m = sink[h] * LOG2E, l = 1.0f;
        f32x16 s0, s1;
        AT_SCORE(s0, s1, F.lds); AT_MASK(s0, s1, 0);
        __syncthreads();
        for (int t = 0; t < nt; ++t) {
            if (t + 2 < nt) { const bf16* g = AT_GP(t + 2); ka0 = *(const v4u*)(g + kcol); ka1 = *(const v4u*)(g + (size_t)32 * EIN + kcol); }
            if (t + 1 < nt) { const bf16* g = AT_GP(t + 1); va0 = *(const v4u*)(g + vcol); va1 = *(const v4u*)(g + (size_t)32 * EIN + vcol); }
            const LAS unsigned char* kbufn = F.lds + ((t + 1) & 1) * AT_BUFB; const LAS unsigned char* vbuf = F.lds + (t & 1) * AT_BUFB + AT_TILEB;
            float rmx = -1e30f;
#pragma unroll
            for (int i = 0; i < 16; ++i) rmx = fmaxf(rmx, fmaxf(s0[i], s1[i]));
            rmx = fmaxf(rmx, shfl_xor_l(rmx, 32, lane));
            const float cand = rmx * SC2;
            if (__builtin_amdgcn_ballot_w64(cand > m + 8.0f) != 0) {
                const float mn = fmaxf(m, cand); const float alpha = __builtin_amdgcn_exp2f(m - mn); m = mn; l *= alpha;
#pragma unroll
                for (int i = 0; i < 16; ++i) { o0[i] *= alpha; o1[i] *= alpha; o2[i] *= alpha; o3[i] *= alpha; } }
            f32x16 n0, n1;
            AT_SCORE(n0, n1, kbufn);
            float rs = 0.f;
#pragma unroll
            for (int i = 0; i < 16; ++i) { const float a = __builtin_amdgcn_exp2f(__builtin_fmaf(s0[i], SC2, -m)), c = __builtin_amdgcn_exp2f(__builtin_fmaf(s1[i], SC2, -m)); s0[i] = a; s1[i] = c; rs += a + c; }
            bf16x8_t pf00, pf01, pf10, pf11;
            { v4u w; w.x = pk2(s0[0], s0[1]); w.y = pk2(s0[2], s0[3]); w.z = pk2(s0[4], s0[5]); w.w = pk2(s0[6], s0[7]); pf00 = __builtin_bit_cast(bf16x8_t, w);
              w.x = pk2(s0[8], s0[9]); w.y = pk2(s0[10], s0[11]); w.z = pk2(s0[12], s0[13]); w.w = pk2(s0[14], s0[15]); pf01 = __builtin_bit_cast(bf16x8_t, w);
              w.x = pk2(s1[0], s1[1]); w.y = pk2(s1[2], s1[3]); w.z = pk2(s1[4], s1[5]); w.w = pk2(s1[6], s1[7]); pf10 = __builtin_bit_cast(bf16x8_t, w);
              w.x = pk2(s1[8], s1[9]); w.y = pk2(s1[10], s1[11]); w.z = pk2(s1[12], s1[13]); w.w = pk2(s1[14], s1[15]); pf11 = __builtin_bit_cast(bf16x8_t, w); }
#pragma unroll
            for (int ks = 0; ks < 8; ++ks) { __builtin_amdgcn_sched_group_barrier(0x100, 2, 0); __builtin_amdgcn_sched_group_barrier(0x008, 2, 0); __builtin_amdgcn_sched_group_barrier(0x002, 14, 0); }
            rs += shfl_xor_l(rs, 32, lane);
            l += rs;
#define AT_VFRAG(dst, db, kbs) do { const v4i16_t lo_ = __builtin_amdgcn_ds_read_tr16_b64_v4i16((LAS v4i16_t*)(vbuf + vrd + (kbs) * 16 * AT_ROWB + (db) * 64)); \
                const v4i16_t hi_ = __builtin_amdgcn_ds_read_tr16_b64_v4i16((LAS v4i16_t*)(vbuf + vrd + ((kbs) * 16 + 8) * AT_ROWB + (db) * 64)); \
                dst = (bf16x8_t){lo_[0], lo_[1], lo_[2], lo_[3], hi_[0], hi_[1], hi_[2], hi_[3]}; } while (0)
#define AT_PV(oacc, db) do { bf16x8_t vf_; AT_VFRAG(vf_, db, 0); oacc = __builtin_amdgcn_mfma_f32_32x32x16_bf16(vf_, pf00, oacc, 0, 0, 0); AT_VFRAG(vf_, db, 1); oacc = __builtin_amdgcn_mfma_f32_32x32x16_bf16(vf_, pf01, oacc, 0, 0, 0); \
                AT_VFRAG(vf_, db, 2); oacc = __builtin_amdgcn_mfma_f32_32x32x16_bf16(vf_, pf10, oacc, 0, 0, 0); AT_VFRAG(vf_, db, 3); oacc = __builtin_amdgcn_mfma_f32_32x32x16_bf16(vf_, pf11, oacc, 0, 0, 0); } while (0)
            AT_PV(o0, 0); AT_PV(o1, 1); AT_PV(o2, 2); AT_PV(o3, 3);
            if (t + 1 < nt) AT_MASK(n0, n1, t + 1);
            if (t + 2 < nt) { LAS unsigned char* kw = F.lds + (t & 1) * AT_BUFB; *(LAS v4u*)(kw + st_off0) = ka0; *(LAS v4u*)(kw + st_off1) = ka1; }
            if (t + 1 < nt) { LAS unsigned char* vw = F.lds + ((t + 1) & 1) * AT_BUFB + AT_TILEB; *(LAS v4u*)(vw + st_off0) = va0; *(LAS v4u*)(vw + st_off1) = va1; }
            __syncthreads();
#pragma unroll
            for (int i = 0; i < 16; ++i) { s0[i] = n0[i]; s1[i] = n1[i]; }
        }
        const float inv = 1.0f / l;
        bf16* orow = MIX + qrow * D + 1024 + h * 128 + 4 * hlf;
#pragma unroll
        for (int g4 = 0; g4 < 4; ++g4) { v2u w;
            w.x = pk2(o0[4 * g4] * inv, o0[4 * g4 + 1] * inv); w.y = pk2(o0[4 * g4 + 2] * inv, o0[4 * g4 + 3] * inv); *(v2u*)(orow + 0 + 8 * g4) = w;
            w.x = pk2(o1[4 * g4] * inv, o1[4 * g4 + 1] * inv); w.y = pk2(o1[4 * g4 + 2] * inv, o1[4 * g4 + 3] * inv); *(v2u*)(orow + 32 + 8 * g4) = w;
            w.x = pk2(o2[4 * g4] * inv, o2[4 * g4 + 1] * inv); w.y = pk2(o2[4 * g4 + 2] * inv, o2[4 * g4 + 3] * inv); *(v2u*)(orow + 64 + 8 * g4) = w;
            w.x = pk2(o3[4 * g4] * inv, o3[4 * g4 + 1] * inv); w.y = pk2(o3[4 * g4 + 2] * inv, o3[4 * g4 + 3] * inv); *(v2u*)(orow + 96 + 8 * g4) = w; }
#undef AT_TROW
#undef AT_GP
#undef AT_SCORE
#undef AT_MASK
#undef AT_VFRAG
#undef AT_PV
    }
}

__device__ __forceinline__ void conv_run(Frame& F, const bf16* GB, const bf16* ZG, bf16* AC, const LAS float* wl, int start, int len, bool head_zero, bool tail_zero) {
    const int c0 = 8 * F.lane; const v4u zero4 = {0u, 0u, 0u, 0u};
    v4u z0[4], z1[4], z2[4], z3[4], g0[4], g1[4], n1[4], n2[4], h0[4], h1[4];
#define CV_LD(dst, base, row) { const bf16* p_ = (base) + (size_t)(row) * D + c0; _Pragma("unroll") for (int j = 0; j < 4; ++j) dst[j] = __builtin_nontemporal_load((const v4u*)(p_ + 512 * j)); }
#define CV_Z0(dst) { _Pragma("unroll") for (int j = 0; j < 4; ++j) dst[j] = zero4; }
    if (head_zero) CV_Z0(z0) else CV_LD(z0, ZG, start - 1)
    CV_LD(z1, ZG, start) CV_LD(z2, ZG, start + 1)
    if (len > 2 || !tail_zero) CV_LD(z3, ZG, start + 2) else CV_Z0(z3)
    CV_LD(g0, GB, start) CV_LD(g1, GB, start + 1)
#pragma unroll 1
    for (int t = 0; t < len; t += 2) { const int m = start + t;
        if (t + 2 < len) { CV_LD(n1, ZG, m + 3) if (t + 4 < len || !tail_zero) CV_LD(n2, ZG, m + 4) else CV_Z0(n2) CV_LD(h0, GB, m + 2) CV_LD(h1, GB, m + 3) }
#pragma unroll
        for (int j = 0; j < 4; ++j) { const LAS float* wp = wl + c0 + 512 * j;
            const f32x4 w0a = *(const LAS f32x4*)(wp), w0b = *(const LAS f32x4*)(wp + 4), w1a = *(const LAS f32x4*)(wp + D), w1b = *(const LAS f32x4*)(wp + D + 4), w2a = *(const LAS f32x4*)(wp + 2 * D), w2b = *(const LAS f32x4*)(wp + 2 * D + 4);
#define CV_H(v, e) (((e) & 1) ? bfhi((v)[(e) >> 1]) : bflo((v)[(e) >> 1]))
#define CV_E(o, e, k, W0, W1, W2, G, ZA, ZB, ZC) o[e] = CV_H(G, e) * (W0[k] * CV_H(ZA, e) + W1[k] * CV_H(ZB, e) + W2[k] * CV_H(ZC, e))
#define CV_ROW(G, ZA, ZB, ZC, mrow) { float o[8]; \
                CV_E(o, 0, 0, w0a, w1a, w2a, G, ZA, ZB, ZC); CV_E(o, 1, 1, w0a, w1a, w2a, G, ZA, ZB, ZC); CV_E(o, 2, 2, w0a, w1a, w2a, G, ZA, ZB, ZC); CV_E(o, 3, 3, w0a, w1a, w2a, G, ZA, ZB, ZC); \
                CV_E(o, 4, 0, w0b, w1b, w2b, G, ZA, ZB, ZC); CV_E(o, 5, 1, w0b, w1b, w2b, G, ZA, ZB, ZC); CV_E(o, 6, 2, w0b, w1b, w2b, G, ZA, ZB, ZC); CV_E(o, 7, 3, w0b, w1b, w2b, G, ZA, ZB, ZC); \
                v4u w; w.x = pk2(o[0], o[1]); w.y = pk2(o[2], o[3]); w.z = pk2(o[4], o[5]); w.w = pk2(o[6], o[7]); *(v4u*)(AC + (size_t)(mrow) * D + c0 + 512 * j) = w; }
            CV_ROW(g0[j], z0[j], z1[j], z2[j], m) CV_ROW(g1[j], z1[j], z2[j], z3[j], m + 1)
#undef CV_ROW
#undef CV_E
#undef CV_H
        }
#pragma unroll
        for (int j = 0; j < 4; ++j) { z0[j] = z2[j]; z1[j] = z3[j]; z2[j] = n1[j]; z3[j] = n2[j]; g0[j] = h0[j]; g1[j] = h1[j]; }
    }
#undef CV_LD
#undef CV_Z0
}
__device__ __forceinline__ void conv_phase(Frame& F, const float* cw, int nrows) {
    const bf16* GB = (const bf16*)(F.ws + WS_G); const bf16* ZG = (const bf16*)(F.ws + WS_ZG); bf16* AC = (bf16*)(F.ws + WS_AC);
    const int gw = F.bid * NWAVES + F.wave, NGW = F.G * NWAVES;
    LAS float* wl = (LAS float*)F.lds;
    { float wv[3 * D / (NWAVES * 64)];
#pragma unroll
      for (int k = 0; k < 3 * D / (NWAVES * 64); ++k) wv[k] = cw[F.tid + k * NWAVES * 64];
#pragma unroll
      for (int k = 0; k < 3 * D / (NWAVES * 64); ++k) wl[F.tid + k * NWAVES * 64] = wv[k]; }
    __syncthreads();
    constexpr int RUN = 16;
    for (int ch = gw; ch < M_TOK / RUN; ch += NGW) { const int st = ch * RUN; conv_run(F, GB, ZG, AC, wl, st, RUN, st % SEQ == 0, (st + RUN) % SEQ == 0); }
    for (int c = F.bid + F.G * F.wave; c < (nrows - M_TOK) / 2; c += NGW) { const int st = M_TOK + 2 * c; conv_run(F, GB, ZG, AC, wl, st, 2, (st - M_TOK) % CTXL == 0, (st + 2 - M_TOK) % CTXL == 0); }
    __syncthreads();
}

struct Args { const float* in[15]; float* out; unsigned char* ws; int ph_lo, ph_hi; };
constexpr int PH_PER_LAYER = 16, PH_BASE = 2, PH_END = PH_BASE + DEPTH * PH_PER_LAYER;

__global__ void __launch_bounds__(NWAVES * 64, 2) dit_fwd(Args args) {
    extern __shared__ __attribute__((aligned(16))) unsigned char lds[];
    Frame F;
    F.lds = (LAS unsigned char*)lds;
    F.MISC = (volatile LAS unsigned*)(F.lds + MISC_OFF);
    F.tid = threadIdx.x; F.lane = F.tid & 63; F.wave = __builtin_amdgcn_readfirstlane(F.tid >> 6);
    F.G = gridDim.x; F.bid = blockIdx.x;
    const int wave0 = F.wave;
    F.ws = args.ws; F.out = args.out; F.ctl = (gu32*)(args.ws + WS_CTL);
    F.x = args.in[0]; F.c = args.in[1]; F.ctx = args.in[2]; F.c_ctx = args.in[3]; F.w_mod = args.in[4]; F.b_mod = args.in[5]; F.gains = args.in[6];
    F.att_w_in = args.in[7]; F.att_sink = args.in[8]; F.att_w_out = args.in[9]; F.conv_w_in = args.in[10]; F.conv_w = args.in[11]; F.conv_w_out = args.in[12];
    F.mlp_w1 = args.in[13]; F.mlp_w2 = args.in[14];
    for (int u = F.tid; u < (LDS_BYTES - LDSCTL_OFF) / 4; u += NWAVES * 64) ((LAS unsigned*)(F.lds + LDSCTL_OFF))[u] = 0u;
    __syncthreads();
    const int lo = args.ph_lo, hi = args.ph_hi;
    const bool multi = (hi - lo) > 1;
    XcdBarrier bar; bar.bar = (unsigned*)(F.ctl + CW_BAR); bar.x = 0; bar.st = nullptr;
    if (multi) bar = xcd_barrier_post((unsigned*)(F.ctl + CW_BAR), F.MISC + 8);
#define RELAUNDER() do { int ln_; asm volatile("v_mbcnt_lo_u32_b32 %0, -1, 0\n\tv_mbcnt_hi_u32_b32 %0, -1, %0" : "=v"(ln_)); int wv_ = wave0; asm volatile("" : "+s"(wv_)); F.lane = ln_; F.wave = wv_; F.tid = wv_ * 64 + ln_; } while (0)
#define IN(k) (RELAUNDER_IN(k))
#define RELAUNDER_IN(k) (lo <= (k) && (k) < hi)
#define SEAM(k) do { if (IN(k) && IN((k) + 1)) xcd_barrier(bar); } while (0)
    const float* MOD = (const float*)(F.ws + WS_MOD);
    bf16* UX = RESID_BF16 ? (bf16*)F.out : (bf16*)(F.ws + WS_XB); bf16* MO = (bf16*)(F.ws + WS_MO);

    { if (IN(0)) { p0_prologue(F, bar); } SEAM(0); }
    if (IN(1)) { r_phase(F, MT, true, false, true, 0, MOD, 0, F.gains, MOD, 0, 1, F.gains); } SEAM(1);

    for (int l = 0; l < DEPTH; ++l) {
        const int pb = PH_BASE + l * PH_PER_LAYER;
        RELAUNDER();
        const float* g = F.gains + (size_t)l * 4 * D;
        const float* modl = MOD + (size_t)l * 3 * NMODV;
        const int a = l >> 1;
        const int Mrows = l < 2 ? MT : M_TOK;
        if ((l & 1) == 0) {
            { RELAUNDER();
                pg8::Gemm gm = pg8::std_gemm(D); gm.hstepB = (size_t)32 * D * 2;
                const bf16* Wt = (const bf16*)(F.ws + WS_WIN_E) + (size_t)a * D * EIN;
                pg8::StdSched S = pg8::std_sched(UX, Wt, M_TOK, EIN, D, F.G, F.bid);
                pg8::EpiInEven E{(bf16*)(F.ws + WS_P), EIN, (const float*)(F.ws + WS_ROPE), M_TOK, SEQ};
                pg8::gemm_phase<pg8::EpiInEven, pg8::StdSched, PG8_ALIGN, PG8_SP2>(F.lds + RING_OFF, gm, S, E, F.tid); }
            xcd_barrier(bar);
            { RELAUNDER();
                pg8::Gemm gm = pg8::std_gemm(D); gm.hstepB = (size_t)32 * D * 2;
                const bf16* Wt = (const bf16*)(F.ws + WS_WIN_E) + (size_t)a * D * EIN;
                pg8::StdSched S = pg8::std_sched(UX + (size_t)M_TOK * D, Wt, M_CTX, EIN, D, F.G, F.bid);
                pg8::EpiInEven E{(bf16*)(F.ws + WS_P) + (size_t)M_TOK * EIN, EIN, (const float*)(F.ws + WS_ROPE), 0, SEQ};
                pg8::gemm_phase<pg8::EpiInEven, pg8::StdSched, PG8_ALIGN, PG8_SP2>(F.lds + RING_OFF, gm, S, E, F.tid); }
            { RELAUNDER(); const int nctx = (M_CTX / 256) * (EIN / 256); const bool split = F.G >= 4 * nctx;
              if (!split || F.bid >= nctx) { pg8::Gemm gm; gm.K = 256; gm.pitchA = 512u; gm.hstepA = (size_t)128 * 512; gm.pitchB = 128u * EIN * 2u; gm.hstepB = (size_t)EIN * 2;
                  pg8::FaHSched S; S.init(4 * 128, split ? F.G - nctx : F.G, split ? F.bid - nctx : F.bid); S.CM = (const char*)(F.ws + WS_DFT + DFT_CMH); S.Pb = (const char*)(F.ws + WS_P); S.pitchP = (size_t)EIN * 2; S.seq = SEQ;
                  pg8::FaHEpi E{(bf16*)(F.ws + WS_Z)};
                  pg8::gemm_phase<pg8::FaHEpi, pg8::FaHSched, PG8_ALIGN, PG8_SP2>(F.lds + RING_OFF, gm, S, E, F.tid); } }
            xcd_barrier(bar);
            { RELAUNDER(); if (l == 0) { pg8::Gemm gm; gm.K = 256; gm.pitchA = 512u; gm.hstepA = (size_t)128 * 512; gm.pitchB = EIN * 2u; gm.hstepB = (size_t)128 * EIN * 2;
                  pg8::FaCtxSched S; S.init(8 * 2, F.G, F.bid); S.CM = (const char*)(F.ws + WS_DFT + DFT_CM); S.Pb = (const char*)(F.ws + WS_P) + (size_t)M_TOK * EIN * 2; S.pitchP = (size_t)EIN * 2;
                  pg8::FaCtxEpi E{(bf16*)(F.ws + WS_ZCTX)};
                  pg8::gemm_phase<pg8::FaCtxEpi, pg8::FaCtxSched, PG8_ALIGN, PG8_SP2>(F.lds + RING_OFF, gm, S, E, F.tid); } }
            {
            RELAUNDER(); if (IN(pb + 3)) {
                pg8::Gemm gm = pg8::std_gemm(256);
                pg8::FbSched S; S.init(516, F.G, F.bid); S.A = (const char*)(F.ws + WS_DFT + DFT_FB1); S.B = (const char*)(F.ws + WS_Z);
                pg8::FbEpi E{(bf16*)(F.ws + WS_A1), (const pg8::f32x2v*)(F.ws + WS_W16K)};
                pg8::gemm_phase<pg8::FbEpi, pg8::FbSched, PG8_ALIGN, PG8_SP2>(F.lds + RING_OFF, gm, S, E, F.tid);
            }
            SEAM(pb + 3);
            RELAUNDER(); if (IN(pb + 4)) {
                { pg8::Gemm gm; gm.K = 256; gm.pitchA = 512u; gm.hstepA = (size_t)128 * 512; gm.pitchB = 128u * 512u; gm.hstepB = (size_t)128 * 128 * 512;
                  pg8::FcSched S; S.init(640, F.G, F.bid); S.A = (const char*)(F.ws + WS_DFT + DFT_FC2); S.B = (const char*)(F.ws + WS_A1);
                  pg8::FcHEpi E{(bf16*)(F.ws + WS_Z), SEQ, D};
                  pg8::gemm_phase<pg8::FcHEpi, pg8::FcSched, PG8_ALIGN, PG8_SP2>(F.lds + RING_OFF, gm, S, E, F.tid); }
                RELAUNDER(); if (l == 0) { pg8::Gemm gm = pg8::std_gemm(512);
                  pg8::FbSched S; S.init(8, F.G, F.bid); S.A = (const char*)(F.ws + WS_DFT + DFT_F256); S.B = (const char*)(F.ws + WS_ZCTX);
                  pg8::CtxSched S2; S2.init(8, F.G, F.bid); S2.A = S.A; S2.B = S.B;
                  pg8::CtxDftEpi E{(bf16*)(F.ws + WS_Z), M_TOK, D};
                  pg8::gemm_phase<pg8::CtxDftEpi, pg8::CtxSched, PG8_ALIGN, PG8_SP2>(F.lds + RING_OFF, gm, S2, E, F.tid); }
                RELAUNDER(); attn_mfma2(F, F.att_sink + a * 8, l == 0);
            }
            SEAM(pb + 4);
            }
        } else {
            { RELAUNDER(); if (IN(pb + 0)) {
                { RELAUNDER();
                    const bf16* Wt = (const bf16*)(F.ws + WS_WIN_O) + (size_t)a * D * OIN; const bf16* Ain = UX; const int Mp = M_TOK; const size_t ro = 0; const int ext = l < 2 ? M_CTX / 256 : 0;
                    { pg8::Gemm gm = pg8::std_gemm(D); pg8::StdSched S = pg8::std_sched(Ain, Wt, Mp, D, D, F.G, F.bid); S.ext_nM = ext;
                      pg8::EpiBf16<0> E{(bf16*)(F.ws + WS_G) + ro, D};
                      pg8::gemm_phase<pg8::EpiBf16<0>, pg8::StdSched, PG8_ALIGN, PG8_SP2>(F.lds + RING_OFF, gm, S, E, F.tid); }
                    RELAUNDER();
                    { pg8::Gemm gm = pg8::std_gemm(D); gm.hstepB = (size_t)2048 * D * 2;
                      pg8::StdSched S = pg8::std_sched(Ain, Wt + (size_t)2048 * D, Mp, 16 * 256, D, F.G, F.bid); S.tsB = (size_t)128 * D * 2; S.ext_nM = ext;
                      pg8::EpiGate E{(bf16*)(F.ws + WS_ZG) + ro, D};
                      pg8::gemm_phase<pg8::EpiGate, pg8::StdSched, PG8_ALIGN, PG8_SP2>(F.lds + RING_OFF, gm, S, E, F.tid); } } } }
            SEAM(pb + 0);
            { RELAUNDER(); if (IN(pb + 1)) { conv_phase(F, F.conv_w + (size_t)a * 3 * D, Mrows); } } SEAM(pb + 1);
        }
        { RELAUNDER(); if (IN(pb + 5)) { const bf16* Ain = (l & 1) ? (const bf16*)(F.ws + WS_AC) : (const bf16*)(F.ws + WS_Z);
            const bf16* Wt = ((l & 1) ? (const bf16*)(F.ws + WS_WOUT_O) : (const bf16*)(F.ws + WS_WOUT_E)) + (size_t)a * D * D;
            { pg8::Gemm gm = pg8::std_gemm(D); pg8::StdSched S = pg8::std_sched(Ain, Wt, M_TOK, D, D, F.G, F.bid);
              pg8::EpiBf16<0> E{MO, D};
              pg8::gemm_phase<pg8::EpiBf16<0>, pg8::StdSched, PG8_ALIGN, PG8_SP2>(F.lds + RING_OFF, gm, S, E, F.tid); }
            RELAUNDER(); if (l < 2) { pg8::Gemm gm = pg8::std_gemm(D); gm.K = 256;
              pg8::SplitKSched S; S.init(8 * 2 * 8, F.G, F.bid); S.A = (const char*)(Ain + (size_t)M_TOK * D); S.B = (const char*)Wt; S.rowpitch = (size_t)D * 2; S.nN = 8; S.Kc = 256;
              pg8::EpiSlab E{(float*)(F.ws + WS_CSP), D};
              pg8::gemm_phase<pg8::EpiSlab, pg8::SplitKSched, PG8_ALIGN, PG8_SP2>(F.lds + RING_OFF, gm, S, E, F.tid); } } }
        SEAM(pb + 5);
        RELAUNDER(); if (IN(pb + 6)) { r_phase(F, Mrows, l == 0, true, true, l < 2 ? 8 : 0, modl, 2, g + D, modl, 3, 4, g + 2 * D); } SEAM(pb + 6);
        RELAUNDER(); if (IN(pb + 7)) {
            { RELAUNDER();
                pg8::Gemm gm = pg8::std_gemm(D); pg8::StdSched S = pg8::std_sched(UX, (const bf16*)(F.ws + WS_W1) + (size_t)l * D * FF, M_TOK, FF, D, F.G, F.bid); S.ext_nM = l < 2 ? M_CTX / 256 : 0;
                pg8::EpiBf16<1> E{(bf16*)(F.ws + WS_H), FF};
                pg8::gemm_phase<pg8::EpiBf16<1>, pg8::StdSched, PG8_ALIGN, PG8_SP2>(F.lds + RING_OFF, gm, S, E, F.tid); } }
        SEAM(pb + 7);
        RELAUNDER(); if (IN(pb + 8)) { const bf16* Wt = (const bf16*)(F.ws + WS_W2) + (size_t)l * D * FF;
            { pg8::Gemm gm = pg8::std_gemm(FF); pg8::StdSched S = pg8::std_sched((const bf16*)(F.ws + WS_H), Wt, M_TOK, D, FF, F.G, F.bid); S.wgm = 4; S.rev = 1;
              pg8::EpiBf16<0> E{MO, D};
              pg8::gemm_phase<pg8::EpiBf16<0>, pg8::StdSched, PG8_ALIGN, PG8_SP2>(F.lds + RING_OFF, gm, S, E, F.tid); }
            RELAUNDER(); if (l < 2) { pg8::Gemm gm = pg8::std_gemm(FF); gm.K = 512;
              pg8::SplitKSched S; S.init(16 * 2 * 8, F.G, F.bid); S.A = (const char*)((const bf16*)(F.ws + WS_H) + (size_t)M_TOK * FF); S.B = (const char*)Wt; S.rowpitch = (size_t)FF * 2; S.nN = 8; S.Kc = 512;
              pg8::EpiSlab E{(float*)(F.ws + WS_CSP), D};
              pg8::gemm_phase<pg8::EpiSlab, pg8::SplitKSched, PG8_ALIGN, PG8_SP2>(F.lds + RING_OFF, gm, S, E, F.tid); } }
        SEAM(pb + 8);
        RELAUNDER(); if (IN(pb + 9)) { const int nr = l < 2 ? MT : M_TOK; const bool ux = l < DEPTH - 1;
            r_phase(F, nr, false, true, ux, l < 2 ? 16 : 0, modl, 5, g + 3 * D, modl + 3 * NMODV, 0, 1, g + 4 * D); }
        if (l < DEPTH - 1) { if (IN(pb + 9) && IN(pb + PH_PER_LAYER)) xcd_barrier(bar); }
    }
#undef IN
#undef SEAM
}

extern "C" void kernel_launch(void* const* d_in, const int* in_sizes, int n_in, void* d_out, int out_size, void* d_ws, size_t ws_size, hipStream_t stream) {
    static int grid = 0;
    if (grid == 0) {
        if (n_in != 15 || out_size != M_TOK * D || ws_size < WS_END) { fprintf(stderr, "kernel_launch: unexpected shapes (n_in %d out %d ws %zu)\n", n_in, out_size, ws_size); grid = -1; return; }
        int dev = 0, cus = 0;
        if (hipGetDevice(&dev) != hipSuccess || hipDeviceGetAttribute(&cus, hipDeviceAttributeMultiprocessorCount, dev) != hipSuccess) { grid = -1; return; }
        if (hipFuncSetAttribute((const void*)dit_fwd, hipFuncAttributeMaxDynamicSharedMemorySize, LDS_BYTES) != hipSuccess) { fprintf(stderr, "kernel_launch: hipFuncSetAttribute failed\n"); grid = -1; return; }
        int per_cu = 0;
        if (hipOccupancyMaxActiveBlocksPerMultiprocessor(&per_cu, (const void*)dit_fwd, NWAVES * 64, LDS_BYTES) != hipSuccess || per_cu < 1) fprintf(stderr, "kernel_launch: occupancy query reports %d\n", per_cu);
        (void)hipGetLastError();
        grid = cus;
    }
    if (grid < 0) return;
    if (hipMemsetAsync((char*)d_ws + WS_CTL, 0, CTL_ZERO_BYTES, stream) != hipSuccess) return;
    Args a{};
    for (int i = 0; i < 15; ++i) a.in[i] = (const float*)d_in[i];
    a.out = (float*)d_out; a.ws = (unsigned char*)d_ws;
    a.ph_lo = 0; a.ph_hi = PH_END;
    hipLaunchKernelGGL(dit_fwd, dim3(grid), dim3(NWAVES * 64), LDS_BYTES, stream, a);
}
```
